# Optimizing an MI355X kernel written in HIP

```python
import math
import jax, jax.numpy as jnp
from jax import lax
import numpy as np

D_MODEL = 1024
BATCH = 16
SEQ = 2048
DEPTH = 2

HEAD_DIM = 64
QBLOCK = 128
N_A = 8
N_B = 8
N_B_KV = 2
WINDOW = 128
N_C = 8
N_IDX = 8
D_IDX = 32
TOPK_MAX = 256
N_D = 8
Q_LORA = 256
KV_LORA = 128
QK_NOPE = 64
QK_ROPE = 32
V_DIM = 64
ROPE_THETA = 10000.0
REL_BUCKETS = 32
REL_MAX_EXACT = 16
REL_MAX_DIST = 128
REL_SLOTS = N_B + N_C
D_FF = 4 * D_MODEL
EPS = 1e-6

EVEN_SIZES = (N_A * HEAD_DIM, N_A * HEAD_DIM, N_A * HEAD_DIM, N_A,
              N_B * HEAD_DIM, N_B_KV * HEAD_DIM, N_B_KV * HEAD_DIM)
EVEN_IN = sum(EVEN_SIZES)
EVEN_OUT = N_A * HEAD_DIM + N_B * HEAD_DIM
ODD_SIZES = (N_C * HEAD_DIM, HEAD_DIM, HEAD_DIM,
             N_IDX * D_IDX, D_IDX, N_IDX,
             Q_LORA, KV_LORA, QK_ROPE)
ODD_IN = sum(ODD_SIZES)
ODD_OUT = N_C * HEAD_DIM + N_D * V_DIM

kernel_name = "hybrid_fox_swa_dsa_mla_trunk"


def _split(h, sizes):
    outs, off = [], 0
    for s in sizes:
        outs.append(h[..., off:off + s])
        off += s
    return outs


def _rmsnorm(x, g):
    xf = x.astype(jnp.float32)
    y = xf * lax.rsqrt(jnp.mean(xf * xf, axis=-1, keepdims=True) + EPS)
    return (y * g.astype(jnp.float32)).astype(x.dtype)


def _t5_bucket(n):
    nf = n.astype(jnp.float32)
    large = REL_MAX_EXACT + (jnp.log(jnp.maximum(nf, float(REL_MAX_EXACT)) / REL_MAX_EXACT)
                             / math.log(REL_MAX_DIST / REL_MAX_EXACT)
                             * (REL_BUCKETS - REL_MAX_EXACT)).astype(jnp.int32)
    large = jnp.minimum(large, REL_BUCKETS - 1)
    return jnp.where(n < REL_MAX_EXACT, n, large)


def _rope_tables(S, dim):
    pos = jnp.arange(S, dtype=jnp.float32)
    inv = ROPE_THETA ** (-jnp.arange(0, dim, 2, dtype=jnp.float32) / dim)
    ang = pos[:, None] * inv[None, :]
    return jnp.cos(ang), jnp.sin(ang)


def _rope(x, cos, sin):
    half = x.shape[-1] // 2
    x1, x2 = x[..., :half], x[..., half:]
    c = cos[None, :, None, :].astype(x.dtype)
    s = sin[None, :, None, :].astype(x.dtype)
    return jnp.concatenate([x1 * c - x2 * s, x1 * s + x2 * c], axis=-1)


def _blocked_causal_attn(q, k, v, log_f_cum=None):
    B, S, H, dq = q.shape
    nb = S // QBLOCK
    scale = dq ** -0.5
    key_pos = jnp.arange(S)
    q_blocks = q.reshape(B, nb, QBLOCK, H, dq).transpose(1, 0, 2, 3, 4)
    starts = jnp.arange(nb) * QBLOCK
    if log_f_cum is not None:
        F_keys = log_f_cum.transpose(0, 2, 1)
        F_blocks = log_f_cum.reshape(B, nb, QBLOCK, H).transpose(1, 0, 2, 3)
        xs = (q_blocks, starts, F_blocks)
    else:
        xs = (q_blocks, starts)

    def one_block(blk):
        qb, start = blk[0], blk[1]
        logits = jnp.einsum("bqhd,bshd->bhqs", qb, k).astype(jnp.float32) * scale
        if log_f_cum is not None:
            Fq = blk[2].astype(jnp.float32).transpose(0, 2, 1)
            logits = logits + Fq[..., None] - F_keys[:, :, None, :].astype(jnp.float32)
        q_pos = start + jnp.arange(QBLOCK)
        mask = key_pos[None, :] <= q_pos[:, None]
        logits = jnp.where(mask[None, None], logits, -jnp.inf)
        p = jax.nn.softmax(logits, axis=-1)
        return jnp.einsum("bhqs,bshd->bqhd", p.astype(v.dtype), v)

    out = lax.map(one_block, xs)
    return out.transpose(1, 0, 2, 3, 4).reshape(B, S, H * v.shape[-1])


def _swa_with_sinks(q, k, v, sinks, bias_table):
    B, S, Hq, d = q.shape
    Hkv = k.shape[2]
    G = Hq // Hkv
    W = WINDOW
    nb = S // W
    qb = q.reshape(B, nb, W, Hkv, G, d)

    def band(a):
        prev = jnp.pad(a, ((0, 0), (W, 0), (0, 0), (0, 0)))[:, :S]
        return jnp.concatenate([prev.reshape(B, nb, W, Hkv, d), a.reshape(B, nb, W, Hkv, d)], axis=2)

    kb, vb = band(k), band(v)
    logits = jnp.einsum("bnqhgd,bnkhd->bnhgqk", qb, kb).astype(jnp.float32) * (d ** -0.5)
    dist = jnp.arange(W)[:, None] + W - jnp.arange(2 * W)[None, :]
    key_pos = jnp.arange(nb)[:, None] * W - W + jnp.arange(2 * W)[None, :]
    mask = ((dist >= 0) & (dist < W))[None] & (key_pos >= 0)[:, None, :]
    bias = bias_table[_t5_bucket(jnp.maximum(dist, 0))]
    bias = bias.reshape(W, 2 * W, Hkv, G).transpose(2, 3, 0, 1).astype(jnp.float32)
    logits = jnp.where(mask[None, :, None, None], logits + bias, -jnp.inf)
    sink = jnp.broadcast_to(sinks.astype(jnp.float32).reshape(Hkv, G, 1, 1), logits.shape[:-1] + (1,))
    p = jax.nn.softmax(jnp.concatenate([logits, sink], axis=-1), axis=-1)[..., :-1]
    out = jnp.einsum("bnhgqk,bnkhd->bnqhgd", p.astype(v.dtype), vb)
    return out.reshape(B, S, Hq * d)


def _dsa_sparse_attn(q, k_c, v_c, q_idx, k_idx, w_idx, bias_table, topk):
    B, S, H, d = q.shape
    nb = S // QBLOCK
    key_pos = jnp.arange(S)
    gather = jax.vmap(lambda a, i: a[i])
    xs = (q.reshape(B, nb, QBLOCK, H, d).transpose(1, 0, 2, 3, 4),
          q_idx.reshape(B, nb, QBLOCK, N_IDX, D_IDX).transpose(1, 0, 2, 3, 4),
          w_idx.reshape(B, nb, QBLOCK, N_IDX).transpose(1, 0, 2, 3),
          jnp.arange(nb) * QBLOCK)

    def one_block(blk):
        qb, qib, wib, start = blk
        q_pos = start + jnp.arange(QBLOCK)
        rel = jax.nn.relu(jnp.einsum("bqhe,bse->bqhs", qib, k_idx).astype(jnp.float32) * (D_IDX ** -0.5))
        score = jnp.einsum("bqhs,bqh->bqs", rel, wib.astype(jnp.float32) * (N_IDX ** -0.5))
        causal = key_pos[None, :] <= q_pos[:, None]
        score = jnp.where(causal[None], score, -jnp.inf)
        _, idx = lax.top_k(score, topk)
        k_sel = gather(k_c, idx)
        v_sel = gather(v_c, idx)
        logits = jnp.einsum("bqhd,bqkd->bqhk", qb, k_sel).astype(jnp.float32) * (d ** -0.5)
        dist = q_pos[None, :, None] - idx
        bias = bias_table[_t5_bucket(jnp.maximum(dist, 0))].transpose(0, 1, 3, 2).astype(jnp.float32)
        logits = jnp.where((dist >= 0)[:, :, None, :], logits + bias, -jnp.inf)
        p = jax.nn.softmax(logits, axis=-1)
        return jnp.einsum("bqhk,bqkd->bqhd", p.astype(v_c.dtype), v_sel)

    out = lax.map(one_block, xs)
    return out.transpose(1, 0, 2, 3, 4).reshape(B, S, H * d)


def _even_mixer(h, w_in, b_f, sinks, w_out, rel_bias):
    B, S, _ = h.shape
    proj = h @ w_in
    qa, ka, va, fa, qb, kb, vb = _split(proj, EVEN_SIZES)
    log_f = jax.nn.log_sigmoid((fa + b_f).astype(jnp.float32))
    F = jnp.cumsum(log_f, axis=1)
    out_a = _blocked_causal_attn(qa.reshape(B, S, N_A, HEAD_DIM), ka.reshape(B, S, N_A, HEAD_DIM),
                                 va.reshape(B, S, N_A, HEAD_DIM), F)
    out_b = _swa_with_sinks(qb.reshape(B, S, N_B, HEAD_DIM), kb.reshape(B, S, N_B_KV, HEAD_DIM),
                            vb.reshape(B, S, N_B_KV, HEAD_DIM), sinks, rel_bias[:, :N_B])
    return jnp.concatenate([out_a, out_b], axis=-1) @ w_out


def _odd_mixer(h, w_in, norm_cq, norm_ckv, w_uq, w_ukv, w_out, rel_bias, topk):
    B, S, _ = h.shape
    proj = h @ w_in
    qc, kc, vc, qi, ki, wi, cq, ckv, kr = _split(proj, ODD_SIZES)
    out_c = _dsa_sparse_attn(qc.reshape(B, S, N_C, HEAD_DIM), kc, vc,
                             qi.reshape(B, S, N_IDX, D_IDX), ki, wi, rel_bias[:, N_B:], topk)
    q_d = (_rmsnorm(cq, norm_cq) @ w_uq).reshape(B, S, N_D, QK_NOPE + QK_ROPE)
    kv_d = (_rmsnorm(ckv, norm_ckv) @ w_ukv).reshape(B, S, N_D, QK_NOPE + V_DIM)
    cos, sin = _rope_tables(S, QK_ROPE)
    q_nope, q_rope = q_d[..., :QK_NOPE], _rope(q_d[..., QK_NOPE:], cos, sin)
    k_nope, v_d = kv_d[..., :QK_NOPE], kv_d[..., QK_NOPE:]
    k_rope = jnp.broadcast_to(_rope(kr[:, :, None, :], cos, sin), (B, S, N_D, QK_ROPE))
    out_d = _blocked_causal_attn(jnp.concatenate([q_nope, q_rope], axis=-1),
                                 jnp.concatenate([k_nope, k_rope], axis=-1), v_d)
    return jnp.concatenate([out_c, out_d], axis=-1) @ w_out


def _mlp(h, w1, w2):
    return jnp.square(jax.nn.relu(h @ w1)) @ w2


def setup_inputs(seed: int = 0) -> dict:
    key = jax.random.key(seed)
    ks = jax.random.split(key, 20)
    NE = (DEPTH + 1) // 2
    NO = DEPTH // 2
    f32 = jnp.float32

    def nrm(k, shape, fan_in):
        return jax.random.normal(k, shape, f32) * (fan_in ** -0.5)

    def gain(k, shape):
        return 1.0 + 0.02 * jax.random.normal(k, shape, f32)

    return {
        "x": jax.random.normal(ks[0], (BATCH, SEQ, D_MODEL), f32),
        "norm_mix_e": gain(ks[1], (NE, D_MODEL)),
        "w_in_e": nrm(ks[2], (NE, D_MODEL, EVEN_IN), D_MODEL),
        "b_forget": 2.0 + 0.5 * jax.random.normal(ks[3], (NE, N_A), f32),
        "sink_logits": 0.5 * jax.random.normal(ks[4], (NE, N_B), f32),
        "w_out_e": nrm(ks[5], (NE, EVEN_OUT, D_MODEL), EVEN_OUT),
        "norm_mix_o": gain(ks[6], (NO, D_MODEL)),
        "w_in_o": nrm(ks[7], (NO, D_MODEL, ODD_IN), D_MODEL),
        "norm_cq": gain(ks[8], (NO, Q_LORA)),
        "norm_ckv": gain(ks[9], (NO, KV_LORA)),
        "w_uq": nrm(ks[10], (NO, Q_LORA, N_D * (QK_NOPE + QK_ROPE)), Q_LORA),
        "w_ukv": nrm(ks[11], (NO, KV_LORA, N_D * (QK_NOPE + V_DIM)), KV_LORA),
        "w_out_o": nrm(ks[12], (NO, ODD_OUT, D_MODEL), ODD_OUT),
        "norm_mlp": gain(ks[13], (DEPTH, D_MODEL)),
        "w_mlp1": nrm(ks[14], (DEPTH, D_MODEL, D_FF), D_MODEL),
        "w_mlp2": nrm(ks[15], (DEPTH, D_FF, D_MODEL), D_FF),
        "rel_bias": 0.5 * jax.random.normal(ks[16], (REL_BUCKETS, REL_SLOTS), f32),
        "norm_final": gain(ks[17], (D_MODEL,)),
    }


def reference(x, norm_mix_e, w_in_e, b_forget, sink_logits, w_out_e,
              norm_mix_o, w_in_o, norm_cq, norm_ckv, w_uq, w_ukv, w_out_o,
              norm_mlp, w_mlp1, w_mlp2, rel_bias, norm_final):
    S = x.shape[1]
    topk = min(TOPK_MAX, S // 4)
    for i in range(DEPTH):
        if i % 2 == 0:
            e = i // 2
            x = x + _even_mixer(_rmsnorm(x, norm_mix_e[e]), w_in_e[e], b_forget[e],
                                sink_logits[e], w_out_e[e], rel_bias)
        else:
            o = i // 2
            x = x + _odd_mixer(_rmsnorm(x, norm_mix_o[o]), w_in_o[o], norm_cq[o], norm_ckv[o],
                               w_uq[o], w_ukv[o], w_out_o[o], rel_bias, topk)
        x = x + _mlp(_rmsnorm(x, norm_mlp[i]), w_mlp1[i], w_mlp2[i])
    return _rmsnorm(x, norm_final)
```

```cpp
#include <hip/hip_runtime.h>
#include <hip/hip_bf16.h>
#include <cstdio>
#include <cstdint>
#include <cmath>
namespace pg8 {
#define PG8_LAS __attribute__((address_space(3)))
typedef unsigned short bf16_t;
typedef short bf16x8 __attribute__((ext_vector_type(8)));
typedef float f32x4 __attribute__((ext_vector_type(4)));
typedef unsigned u32x4 __attribute__((ext_vector_type(4)));
constexpr int BM = 256, BK = 64, HALF = 128, HTB = HALF * BK * 2  , STAGE_BYTES = 8 * HTB, NXCD = 8, WGM = 8;

__host__ __device__ __forceinline__ int lds_byte(int r, int c) { const int st = (r >> 4) * 2 + (c >> 5), rr = r & 15, cc = c & 31, ob = rr * 64 + cc * 2; return st * 1024 + (ob ^ (((ob >> 9) & 1) << 5)); }
__host__ __device__ __forceinline__ void stage_rc(int b, int& R, int& C) { const int st = b / 1024, sb = b % 1024, swz = sb ^ (((sb >> 9) & 1) << 5); R = (st >> 1) * 16 + swz / 64; C = (st & 1) * 32 + (swz % 64) / 2; }
__host__ __device__ __forceinline__ int perm32(int rho) { const int n = rho >> 4, i = rho & 15; return 8 * (i >> 2) + 4 * n + (i & 3); }

struct Unit { int pm, pn; };
struct Gemm { const bf16_t* A; const bf16_t* Bt; int M, N, K, lda; };

struct StaticOrder {
    int nM, nN, nwg, G, c;
    __host__ __device__ void init(int M, int N, int G_, int c_) { nM = M / BM; nN = N / BM; nwg = nM * nN; G = G_; c = c_; }
    __host__ __device__ bool next(int i, Unit& u) const {
        const long L = (long)i * G + c; if (L >= nwg) return false;
        int wgid = (int)L; { const int q = nwg / NXCD, r = nwg % NXCD, xcd = wgid % NXCD, off = wgid / NXCD; wgid = (xcd < r ? xcd * (q + 1) : r * (q + 1) + (xcd - r) * q) + off; }
        const int nig = WGM * nN, gid = wgid / nig, fm = gid * WGM, gsz = (nM - fm) < WGM ? (nM - fm) : WGM;
        u.pm = fm + ((wgid % nig) % gsz); u.pn = (wgid % nig) / gsz; return true;
    }
    __device__ __forceinline__ void a_ready(const Unit&) const {}
    __device__ __forceinline__ void done(const Unit&) const {}
};


typedef unsigned u32x2 __attribute__((ext_vector_type(2)));
typedef float f32x2e __attribute__((ext_vector_type(2)));
typedef __bf16 bf16x2e __attribute__((ext_vector_type(2)));
__device__ __forceinline__ unsigned cvt2(float lo, float hi) { f32x2e v = {lo, hi}; bf16x2e b = __builtin_convertvector(v, bf16x2e); return __builtin_bit_cast(unsigned, b); }
__device__ __forceinline__ u32x4 pack8(const f32x4 a, const f32x4 b) { u32x4 w; w.x = cvt2(a[0], a[1]); w.y = cvt2(a[2], a[3]); w.z = cvt2(b[0], b[1]); w.w = cvt2(b[2], b[3]); return w; }
constexpr float RMS_EPS = 1e-6f;
__device__ __forceinline__ float row_rstd16(const float* ssP, int row, int fq, float invn) {
    const f32x4 p = *(const f32x4*)(ssP + (size_t)row * 16 + 4 * fq); float s = (p[0] + p[1]) + (p[2] + p[3]);
    s += __shfl_xor(s, 16); s += __shfl_xor(s, 32); return 1.0f / sqrtf(s * invn + RMS_EPS);
}
__device__ __forceinline__ float row_rstd4(const float* ssP, int row, int fq, float invn) {
    float s = ssP[(size_t)row * 4 + fq]; s += __shfl_xor(s, 16); s += __shfl_xor(s, 32); return 1.0f / sqrtf(s * invn + RMS_EPS);
}
__device__ __forceinline__ float sq8(const f32x4 a, const f32x4 b) { return ((a[0] * a[0] + a[1] * a[1]) + (a[2] * a[2] + a[3] * a[3])) + ((b[0] * b[0] + b[1] * b[1]) + (b[2] * b[2] + b[3] * b[3])); }

template <int ACT> struct EpiNormBf16 {
    static constexpr bool PERM = true, AFTER_DRAIN = false;
    bf16_t* O; int ldc; const float* ssP; unsigned qmask; float qscale;
    __device__ __forceinline__ void operator()(const f32x4 (&acc)[2][2][4][2], const Unit& u, int wr, int wc, int fr, int fq) const {
        const int row0 = u.pm * BM + wr * 64 + fr, col0 = u.pn * BM + wc * 32 + 8 * fq;
        const float ts = ((qmask >> u.pn) & 1u) ? qscale : 1.f;
#pragma unroll
        for (int ai = 0; ai < 2; ++ai)
#pragma unroll
            for (int m = 0; m < 4; ++m) { const int row = row0 + ai * HALF + m * 16; const float rs = row_rstd16(ssP, row, fq, 1.0f / 1024.0f) * ts;
                bf16_t* rowp = O + (size_t)row * ldc + col0;
#pragma unroll
                for (int bj = 0; bj < 2; ++bj) { f32x4 v0 = acc[ai][bj][m][0] * rs, v1 = acc[ai][bj][m][1] * rs;
                    if (ACT == 1) {
#pragma unroll
                        for (int e = 0; e < 4; ++e) { const float a = fmaxf(v0[e], 0.f), b = fmaxf(v1[e], 0.f); v0[e] = a * a; v1[e] = b * b; } }
                    *(u32x4*)(rowp + bj * HALF) = pack8(v0, v1); } }
    }
};
template <bool WRITE_XB> struct EpiResid {
    static constexpr bool PERM = true, AFTER_DRAIN = false;
    const float* res; float* xout; bf16_t* xb; float* ssOut;
    __device__ __forceinline__ void operator()(const f32x4 (&acc)[2][2][4][2], const Unit& u, int wr, int wc, int fr, int fq) const {
        const int row0 = u.pm * BM + wr * 64 + fr, col0 = u.pn * BM + wc * 32 + 8 * fq;
#pragma unroll
        for (int ai = 0; ai < 2; ++ai)
#pragma unroll
            for (int m = 0; m < 4; ++m) { const int row = row0 + ai * HALF + m * 16; const size_t off = (size_t)row * 1024 + col0; float s = 0.f;
#pragma unroll
                for (int bj = 0; bj < 2; ++bj) { const f32x4 r0 = *(const f32x4*)(res + off + bj * HALF), r1 = *(const f32x4*)(res + off + bj * HALF + 4);
                    const f32x4 v0 = acc[ai][bj][m][0] + r0, v1 = acc[ai][bj][m][1] + r1;
                    *(f32x4*)(xout + off + bj * HALF) = v0; *(f32x4*)(xout + off + bj * HALF + 4) = v1;
                    if (WRITE_XB) *(u32x4*)(xb + off + bj * HALF) = pack8(v0, v1);
                    s += sq8(v0, v1); }
                s += __shfl_xor(s, 16); s += __shfl_xor(s, 32);
                if (fq == 0) ssOut[(size_t)row * 16 + u.pn * 4 + wc] = s; }
    }
};
struct EpiInOdd {
    static constexpr bool PERM = true, AFTER_DRAIN = false;
    bf16_t* PO; const float* ssP; float qscale; float* ssq; float* sskv; bf16_t* Kd; float* WI; const float* rope;
    __device__ __forceinline__ void operator()(const f32x4 (&acc)[2][2][4][2], const Unit& u, int wr, int wc, int fr, int fq) const {
        const int row0 = u.pm * BM + wr * 64 + fr, col0 = u.pn * BM + wc * 32 + 8 * fq;
        const float ts = (u.pn < 2) ? qscale : 1.f;
#pragma unroll
        for (int ai = 0; ai < 2; ++ai)
#pragma unroll
            for (int m = 0; m < 4; ++m) { const int row = row0 + ai * HALF + m * 16; const float rs = row_rstd16(ssP, row, fq, 1.0f / 1024.0f) * ts;
                bf16_t* rowp = PO + (size_t)row * 1536 + col0;
                const f32x4 a0 = acc[ai][0][m][0] * rs, a1 = acc[ai][0][m][1] * rs, b0 = acc[ai][1][m][0] * rs, b1 = acc[ai][1][m][1] * rs;
                *(u32x4*)(rowp) = pack8(a0, a1); *(u32x4*)(rowp + HALF) = pack8(b0, b1);
                if (u.pn == 2) { float s = sq8(a0, a1) + sq8(b0, b1); s += __shfl_xor(s, 16); s += __shfl_xor(s, 32); if (fq == 0) ssq[(size_t)row * 4 + wc] = s; }
                if (u.pn == 4) { float s = sq8(a0, a1); s += __shfl_xor(s, 16); s += __shfl_xor(s, 32); if (fq == 0) sskv[(size_t)row * 4 + wc] = s; }
                if (u.pn == 5) {
                    if (wc == 1) {
                        const int pos = row & 2047, i0 = 8 * (fq & 1); const float* rp = rope + ((size_t)pos * 16 + i0) * 2;
                        f32x4 o0, o1;
#pragma unroll
                        for (int e = 0; e < 8; ++e) { const float v = e < 4 ? a0[e] : a1[e - 4]; const float w = __shfl_xor(v, 32); const float c = rp[2 * e], sn = rp[2 * e + 1];
                            const float o = (fq < 2) ? (v * c - w * sn) : (w * sn + v * c); if (e < 4) o0[e] = o; else o1[e - 4] = o; }
                        const u32x4 pk = pack8(o0, o1);
#pragma unroll
                        for (int h = 0; h < 8; ++h) *(u32x4*)(Kd + (size_t)row * 768 + h * 96 + 64 + 8 * fq) = pk;
                    }
                    if (wc == 2 && fq == 0) { *(f32x4*)(WI + (size_t)row * 8) = a0; *(f32x4*)(WI + (size_t)row * 8 + 4) = a1; }
                } }
    }
};
struct EpiUq {
    static constexpr bool PERM = true, AFTER_DRAIN = false;
    bf16_t* Qd; const float* ssq; float qscale; const float* rope;
    __device__ __forceinline__ void operator()(const f32x4 (&acc)[2][2][4][2], const Unit& u, int wr, int wc, int fr, int fq) const {
        const int row0 = u.pm * BM + wr * 64 + fr, col0 = u.pn * BM + wc * 32 + 8 * fq;
#pragma unroll
        for (int ai = 0; ai < 2; ++ai)
#pragma unroll
            for (int m = 0; m < 4; ++m) { const int row = row0 + ai * HALF + m * 16; const float rs = row_rstd4(ssq, row, fq, 1.0f / 256.0f) * qscale;
                bf16_t* rowp = Qd + (size_t)row * 768 + col0; const int pos = row & 2047; const float* rp = rope + ((size_t)pos * 16 + 8 * (fq & 1)) * 2;
#pragma unroll
                for (int bj = 0; bj < 2; ++bj) { f32x4 v0 = acc[ai][bj][m][0] * rs, v1 = acc[ai][bj][m][1] * rs;
                    const int g = u.pn * 8 + bj * 4 + wc;
                    if (g % 3 == 2) { f32x4 o0, o1;
#pragma unroll
                        for (int e = 0; e < 8; ++e) { const float v = e < 4 ? v0[e] : v1[e - 4]; const float w = __shfl_xor(v, 32); const float c = rp[2 * e], sn = rp[2 * e + 1];
                            const float o = (fq < 2) ? (v * c - w * sn) : (w * sn + v * c); if (e < 4) o0[e] = o; else o1[e - 4] = o; }
                        v0 = o0; v1 = o1; }
                    *(u32x4*)(rowp + bj * HALF) = pack8(v0, v1); } }
    }
};
struct EpiUkv {
    static constexpr bool PERM = true, AFTER_DRAIN = false;
    bf16_t* Kd; bf16_t* Vd; const float* sskv;
    __device__ __forceinline__ void operator()(const f32x4 (&acc)[2][2][4][2], const Unit& u, int wr, int wc, int fr, int fq) const {
        const int row0 = u.pm * BM + wr * 64 + fr;
#pragma unroll
        for (int ai = 0; ai < 2; ++ai)
#pragma unroll
            for (int m = 0; m < 4; ++m) { const int row = row0 + ai * HALF + m * 16; const float rs = row_rstd4(sskv, row, fq, 1.0f / 128.0f);
#pragma unroll
                for (int bj = 0; bj < 2; ++bj) { const f32x4 v0 = acc[ai][bj][m][0] * rs, v1 = acc[ai][bj][m][1] * rs; const int h = u.pn * 2 + bj, j = wc * 32 + 8 * fq;
                    bf16_t* dst = (wc < 2) ? (Kd + (size_t)row * 768 + h * 96 + j) : (Vd + (size_t)row * 512 + h * 64 + (j - 64));
                    *(u32x4*)dst = pack8(v0, v1); } }
    }
};

template <class Epi, class Sched, bool ALIGN_EPI = false, bool SP2 = false>
__device__ __forceinline__ void gemm_phase(PG8_LAS unsigned char* lds, const Gemm g, const Sched& S, const Epi& E) {
    const int tid = threadIdx.x, wid = __builtin_amdgcn_readfirstlane(tid >> 6), lane = tid & 63, wr = wid >> 2, wc = wid & 3, fr = lane & 15, fq = lane >> 4;
    const int K = g.K, nt = K / BK;
    unsigned voffA[2], voffB[2];
#pragma unroll
    for (int i = 0; i < 2; ++i) { int R, C; stage_rc(tid * 16 + i * 8192, R, C); const int Rb = Epi::PERM ? ((R & ~31) + perm32(R & 31)) : R;
        voffA[i] = (unsigned)(R * g.lda + C) * 2u; voffB[i] = (unsigned)(Rb * K + C) * 2u; }
    const size_t kstep = (size_t)(BK * 2);
    const size_t hstep = (size_t)HALF * K * 2;
    const size_t tstep = 2 * hstep; const size_t hstepA = (size_t)HALF * g.lda * 2, tstepA = 2 * hstepA;
    const unsigned ldsw = (unsigned)wid * 1024u;
    const int aoff = lds_byte(wr * 64 + fr, fq * 8), boff = lds_byte(wc * 32 + fr, fq * 8);
#define PG8_SA(b, h) (((b) * 2 + (h)) * HTB)
#define PG8_SB(b, h) ((4 + (b) * 2 + (h)) * HTB)
#define PG8_STAGE(bufoff, gbase, voff) do { _Pragma("unroll") for (int _i = 0; _i < 2; ++_i) \
        __builtin_amdgcn_global_load_lds((const unsigned*)((const char*)(gbase) + (voff)[_i]), (PG8_LAS unsigned*)(lds + (bufoff) + ldsw + _i * 8192), 16, 0, 0); } while (0)
#define PG8_LDA(dst, b, h) do { _Pragma("unroll") for (int m = 0; m < 4; ++m) _Pragma("unroll") for (int k = 0; k < 2; ++k) dst[m][k] = *(const PG8_LAS bf16x8*)(lds + PG8_SA(b, h) + aoff + m * 2048 + k * 1024); } while (0)
#define PG8_LDB(dst, b, h) do { _Pragma("unroll") for (int n = 0; n < 2; ++n) _Pragma("unroll") for (int k = 0; k < 2; ++k) dst[n][k] = *(const PG8_LAS bf16x8*)(lds + PG8_SB(b, h) + boff + n * 2048 + k * 1024); } while (0)
#define PG8_MMA(ai, bj, At, Bt) do { __builtin_amdgcn_s_setprio(1); _Pragma("unroll") for (int m = 0; m < 4; ++m) _Pragma("unroll") for (int n = 0; n < 2; ++n) _Pragma("unroll") for (int k = 0; k < 2; ++k) \
        acc[ai][bj][m][n] = __builtin_amdgcn_mfma_f32_16x16x32_bf16(Bt[n][k], At[m][k], acc[ai][bj][m][n], 0, 0, 0); __builtin_amdgcn_s_setprio(0); } while (0)
#define PG8_WAIT_V(n) asm volatile("s_waitcnt vmcnt(" #n ")" ::: "memory")
#define PG8_WAIT_L(n) asm volatile("s_waitcnt lgkmcnt(" #n ")" ::: "memory")
#define PG8_BAR __builtin_amdgcn_s_barrier()
#define PG8_SCHED __builtin_amdgcn_sched_barrier(0)
    Unit cur, nxt; int ui = 0;
    if (!S.next(0, cur)) return;
    f32x4 acc[2][2][4][2];
#pragma unroll
    for (int a = 0; a < 2; ++a)
#pragma unroll
        for (int b = 0; b < 2; ++b)
#pragma unroll
            for (int m = 0; m < 4; ++m)
#pragma unroll
                for (int n = 0; n < 2; ++n) acc[a][b][m][n] = (f32x4){0.f, 0.f, 0.f, 0.f};
    bf16x8 At[4][2], B0[2][2], B1[2][2];
    const char* cA = (const char*)g.A + (size_t)cur.pm * tstepA; const char* cB = (const char*)g.Bt + (size_t)cur.pn * tstep;
    S.a_ready(cur);
    if constexpr (SP2) {
        PG8_STAGE(PG8_SB(0, 0), cB, voffB); PG8_STAGE(PG8_SB(0, 1), cB + hstep, voffB); PG8_STAGE(PG8_SA(0, 0), cA, voffA); PG8_STAGE(PG8_SA(0, 1), cA + hstepA, voffA);
        if (wr == 1) PG8_BAR;
        PG8_WAIT_V(2); PG8_BAR;
        PG8_STAGE(PG8_SB(1, 0), cB + kstep, voffB); PG8_STAGE(PG8_SA(1, 0), cA + kstep, voffA); PG8_STAGE(PG8_SB(1, 1), cB + hstep + kstep, voffB);
        PG8_WAIT_V(6); PG8_BAR;
    } else {
        PG8_STAGE(PG8_SB(0, 0), cB, voffB); PG8_STAGE(PG8_SA(0, 0), cA, voffA); PG8_STAGE(PG8_SB(0, 1), cB + hstep, voffB); PG8_STAGE(PG8_SA(0, 1), cA + hstepA, voffA);
        if (wr == 1) PG8_BAR;
        PG8_WAIT_V(4); PG8_BAR;
        PG8_STAGE(PG8_SB(1, 0), cB + kstep, voffB); PG8_STAGE(PG8_SA(1, 0), cA + kstep, voffA); PG8_STAGE(PG8_SB(1, 1), cB + hstep + kstep, voffB);
        PG8_WAIT_V(6); PG8_BAR;
    }
    for (;;) {
        const bool has_next = S.next(ui + 1, nxt);
        const char* nA = has_next ? (const char*)g.A + (size_t)nxt.pm * tstepA : cA; const char* nB = has_next ? (const char*)g.Bt + (size_t)nxt.pn * tstep : cB;
        for (int t = 0; t < nt; t += 2) {
            const bool last = (t == nt - 2);
            const char* a1 = cA + (size_t)(t + 1) * kstep;
            const char* a2 = last ? nA : cA + (size_t)(t + 2) * kstep; const char* b2 = last ? nB : cB + (size_t)(t + 2) * kstep;
            const char* a3 = a2 + kstep; const char* b3 = b2 + kstep;
            if (last && has_next) S.a_ready(nxt);
            if constexpr (SP2) {
            PG8_LDB(B0, 0, 0); PG8_LDB(B1, 0, 1); PG8_SCHED; PG8_LDA(At, 0, 0); PG8_STAGE(PG8_SA(1, 1), a1 + hstepA, voffA);
            PG8_WAIT_V(8); PG8_WAIT_L(0); PG8_BAR; PG8_MMA(0, 0, At, B0); PG8_MMA(0, 1, At, B1); PG8_BAR; PG8_SCHED;
            PG8_LDA(At, 0, 1); PG8_STAGE(PG8_SB(0, 0), b2, voffB); PG8_STAGE(PG8_SB(0, 1), b2 + hstep, voffB); PG8_STAGE(PG8_SA(0, 0), a2, voffA);
            PG8_WAIT_V(8); PG8_WAIT_L(0); PG8_BAR; PG8_MMA(1, 0, At, B0); PG8_MMA(1, 1, At, B1); PG8_BAR; PG8_SCHED;
            PG8_LDB(B0, 1, 0); PG8_LDB(B1, 1, 1); PG8_SCHED; PG8_LDA(At, 1, 0); PG8_STAGE(PG8_SA(0, 1), a2 + hstepA, voffA);
            PG8_WAIT_V(8); PG8_WAIT_L(0); PG8_BAR; PG8_MMA(0, 0, At, B0); PG8_MMA(0, 1, At, B1); PG8_BAR; PG8_SCHED;
            PG8_LDA(At, 1, 1); PG8_STAGE(PG8_SB(1, 0), b3, voffB); PG8_STAGE(PG8_SB(1, 1), b3 + hstep, voffB); PG8_STAGE(PG8_SA(1, 0), a3, voffA);
            PG8_WAIT_V(8); PG8_WAIT_L(0); PG8_BAR; PG8_MMA(1, 0, At, B0); PG8_MMA(1, 1, At, B1); PG8_BAR; PG8_SCHED;
            } else {
            PG8_LDB(B0, 0, 0); PG8_SCHED; PG8_LDA(At, 0, 0); PG8_STAGE(PG8_SA(1, 1), a1 + hstepA, voffA);
            PG8_WAIT_L(8); PG8_BAR; PG8_WAIT_L(0); PG8_MMA(0, 0, At, B0); PG8_BAR; PG8_SCHED;
            PG8_LDB(B1, 0, 1); PG8_STAGE(PG8_SB(0, 0), b2, voffB);
            PG8_BAR; PG8_WAIT_L(0); PG8_MMA(0, 1, At, B1); PG8_BAR;
            PG8_LDA(At, 0, 1); PG8_STAGE(PG8_SA(0, 0), a2, voffA);
            PG8_BAR; PG8_WAIT_L(0); PG8_MMA(1, 0, At, B0); PG8_BAR; PG8_SCHED;
            PG8_STAGE(PG8_SB(0, 1), b2 + hstep, voffB);
            PG8_WAIT_V(6); PG8_BAR; PG8_MMA(1, 1, At, B1); PG8_BAR;
            PG8_LDB(B0, 1, 0); PG8_SCHED; PG8_LDA(At, 1, 0); PG8_STAGE(PG8_SA(0, 1), a2 + hstepA, voffA);
            PG8_WAIT_L(8); PG8_BAR; PG8_WAIT_L(0); PG8_MMA(0, 0, At, B0); PG8_BAR; PG8_SCHED;
            PG8_LDB(B1, 1, 1); PG8_STAGE(PG8_SB(1, 0), b3, voffB);
            PG8_BAR; PG8_WAIT_L(0); PG8_MMA(0, 1, At, B1); PG8_BAR;
            PG8_LDA(At, 1, 1); PG8_STAGE(PG8_SA(1, 0), a3, voffA);
            PG8_BAR; PG8_WAIT_L(0); PG8_MMA(1, 0, At, B0); PG8_BAR; PG8_SCHED;
            PG8_STAGE(PG8_SB(1, 1), b3 + hstep, voffB);
            PG8_WAIT_V(6); PG8_BAR; PG8_MMA(1, 1, At, B1); PG8_BAR;
            }
        }
        if constexpr (ALIGN_EPI) { if (wr == 0) PG8_BAR; }
        if constexpr (!Epi::AFTER_DRAIN) { E(acc, cur, wr, wc, fr, fq); S.done(cur); }
        if (!has_next) break;
#pragma unroll
        for (int a = 0; a < 2; ++a)
#pragma unroll
            for (int b = 0; b < 2; ++b)
#pragma unroll
                for (int m = 0; m < 4; ++m)
#pragma unroll
                    for (int n = 0; n < 2; ++n) acc[a][b][m][n] = (f32x4){0.f, 0.f, 0.f, 0.f};
        cur = nxt; cA = nA; cB = nB; ++ui;
        if constexpr (ALIGN_EPI) { if (wr == 1) PG8_BAR; }
    }
    PG8_WAIT_V(0);
    if constexpr (!ALIGN_EPI) { if (wr == 0) PG8_BAR; }
    PG8_BAR;
    if constexpr (Epi::AFTER_DRAIN) { E.fused(acc, cur, wr, wc, fr, fq, lds, wid, lane); S.done(cur); }
#undef PG8_SA
#undef PG8_SB
#undef PG8_STAGE
#undef PG8_LDA
#undef PG8_LDB
#undef PG8_MMA
#undef PG8_WAIT_V
#undef PG8_WAIT_L
#undef PG8_BAR
#undef PG8_SCHED
}
}

namespace att {
#define ALAS __attribute__((address_space(3)))
typedef unsigned short bf16_t;
typedef short bf16x8 __attribute__((ext_vector_type(8)));
typedef short s16x4 __attribute__((ext_vector_type(4)));
typedef float f32x4 __attribute__((ext_vector_type(4)));
typedef float f32x16 __attribute__((ext_vector_type(16)));
typedef unsigned u32x4 __attribute__((ext_vector_type(4)));
typedef unsigned u32x2 __attribute__((ext_vector_type(2)));
typedef float f32x2_t __attribute__((ext_vector_type(2))); typedef __bf16 bf16x2_t __attribute__((ext_vector_type(2)));
constexpr float LOG2E = 1.4426950408889634f;
constexpr int BIAS_LDS_OFF = 65536;
__device__ __forceinline__ unsigned cvtpk(float lo, float hi) { f32x2_t v = {lo, hi}; bf16x2_t b = __builtin_convertvector(v, bf16x2_t); return __builtin_bit_cast(unsigned, b); }
__device__ __forceinline__ s16x4 vtr(const ALAS unsigned char* p) { typedef short v4i16_t __attribute__((ext_vector_type(4))); return __builtin_bit_cast(s16x4, __builtin_amdgcn_ds_read_tr16_b64_v4i16((ALAS v4i16_t*)p)); }
__device__ __forceinline__ int crow(int i, int hi) { return (i & 3) + 8 * (i >> 2) + 4 * hi; }

struct AU {
    const bf16_t* Q; int ldq;
    const bf16_t* K; int ldk;
    const bf16_t* V; int ldv;
    bf16_t* O; int ldo;
    int tok0;
    int qpos;
    int t_lo, t_hi;
    const float* F2; float cb;
    const ALAS float* bias;
    float sink2;
    const unsigned long long* bm;
};

template <int DK, int MODE>
__device__ __forceinline__ void attn_unit(const AU& u, ALAS unsigned char* lds) {
    constexpr int KSTR = DK * 2 + 16, KB = 64 * KSTR, VB = 8192, BUF = KB + VB + 256, NKS = DK / 16, CPR = DK / 8;
    static_assert(2 * BUF <= BIAS_LDS_OFF, "attention ring vs bias tables");
    const int tid = threadIdx.x, lane = tid & 63, r32 = lane & 31, hi = lane >> 5;
    const int q = u.qpos + r32;
    bf16x8 qr[NKS];
    { const bf16_t* qp = u.Q + (size_t)(u.tok0 + q) * u.ldq + hi * 8;
#pragma unroll
      for (int ks = 0; ks < NKS; ++ks) qr[ks] = *(const bf16x8*)(qp + ks * 16); }
    const int kr0 = tid / CPR, kc0 = tid % CPR, kr1 = (tid + 512) / CPR, kc1 = (tid + 512) % CPR;
    const int vr = tid >> 3, vc = tid & 7;
    const unsigned kdst0 = kr0 * KSTR + kc0 * 16, kdst1 = kr1 * KSTR + kc1 * 16;
    const unsigned vdst = KB + ((vr >> 2) * 2 + (vc >> 2)) * 256 + (vr & 3) * 64 + (vc & 3) * 16;
    const bf16_t* kg0 = u.K + (size_t)(u.tok0 + kr0) * u.ldk + kc0 * 8;
    const bf16_t* kg1 = u.K + (size_t)(u.tok0 + kr1) * u.ldk + kc1 * 8;
    const bf16_t* vg = u.V + (size_t)(u.tok0 + vr) * u.ldv + vc * 8;
    const bool k2 = (DK == 96) && (tid < 256);
    u32x4 kreg0, kreg1 = {0u, 0u, 0u, 0u}, vreg; float fkv = 0.f;
#define AT_LOAD(t) do { const size_t ro_ = (size_t)(t) * 64; kreg0 = *(const u32x4*)(kg0 + ro_ * u.ldk); if (k2) kreg1 = *(const u32x4*)(kg1 + ro_ * u.ldk); \
        vreg = *(const u32x4*)(vg + ro_ * u.ldv); if (MODE == 0) { if (tid < 64) fkv = u.F2[(t) * 64 + tid]; } } while (0)
#define AT_STORE(buf) do { ALAS unsigned char* b_ = lds + (buf) * BUF; *(ALAS u32x4*)(b_ + kdst0) = kreg0; if (k2) *(ALAS u32x4*)(b_ + kdst1) = kreg1; \
        *(ALAS u32x4*)(b_ + vdst) = vreg; if (MODE == 0) { if (tid < 64) *(ALAS float*)(b_ + KB + VB + tid * 4) = fkv; } } while (0)
    float m = -1e30f, l = 0.f; f32x16 o0 = f32x16{}, o1 = f32x16{};
    const unsigned koff = r32 * KSTR + hi * 16;
    const unsigned vbase = KB + hi * 512 + ((lane & 15) >> 2) * 64 + ((lane >> 4) & 1) * 32 + (lane & 3) * 8;
    AT_LOAD(u.t_lo); AT_STORE(0);
    __syncthreads();
    for (int t = u.t_lo; t < u.t_hi; ++t) {
        const int cur = (t - u.t_lo) & 1; const bool more = (t + 1 < u.t_hi);
        if (more) AT_LOAD(t + 1);
        const int kt0 = t * 64;
        const bool active = (MODE == 1) ? true : (kt0 <= u.qpos + 31);
        if (active) {
            const ALAS unsigned char* Kb = lds + cur * BUF;
            unsigned long long mw = 0ull;
            if (MODE == 2) mw = u.bm[(size_t)q * 32 + t];
            f32x16 p0, p1;
            if (MODE == 0) { const ALAS float* fk = (const ALAS float*)(Kb + KB + VB);
#pragma unroll
                for (int g = 0; g < 4; ++g) { const f32x4 a = *(const ALAS f32x4*)(fk + 8 * g + 4 * hi), b = *(const ALAS f32x4*)(fk + 32 + 8 * g + 4 * hi);
#pragma unroll
                    for (int e = 0; e < 4; ++e) { p0[4 * g + e] = u.cb - a[e]; p1[4 * g + e] = u.cb - b[e]; } } }
            else { p0 = f32x16{}; p1 = f32x16{}; }
#pragma unroll
            for (int ks = 0; ks < NKS; ++ks) {
                const bf16x8 k0 = *(const ALAS bf16x8*)(Kb + koff + ks * 32), k1 = *(const ALAS bf16x8*)(Kb + koff + 32 * KSTR + ks * 32);
                p0 = __builtin_amdgcn_mfma_f32_32x32x16_bf16(k0, qr[ks], p0, 0, 0, 0);
                p1 = __builtin_amdgcn_mfma_f32_32x32x16_bf16(k1, qr[ks], p1, 0, 0, 0);
            }
            if (MODE == 0 || MODE == 3) {
                if (kt0 + 63 > u.qpos) {
#pragma unroll
                    for (int i = 0; i < 16; ++i) { const int key = kt0 + crow(i, hi); if (key > q) p0[i] = -INFINITY; if (key + 32 > q) p1[i] = -INFINITY; } }
            } else if (MODE == 1) {
#pragma unroll
                for (int i = 0; i < 16; ++i) { const int d0 = q - (kt0 + crow(i, hi)), d1 = d0 - 32;
                    const bool v0 = (unsigned)d0 < 128u, v1 = (unsigned)d1 < 128u;
                    const float b0 = u.bias[v0 ? d0 : 0], b1 = u.bias[v1 ? d1 : 0];
                    p0[i] = v0 ? p0[i] + b0 : -INFINITY; p1[i] = v1 ? p1[i] + b1 : -INFINITY; }
            } else {
                const unsigned lo = (unsigned)mw >> (4 * hi), hw = (unsigned)(mw >> 32) >> (4 * hi);
#pragma unroll
                for (int i = 0; i < 16; ++i) { const int bit = (i & 3) + 8 * (i >> 2); const int d0 = q - (kt0 + crow(i, hi)), d1 = d0 - 32;
                    const int i0 = d0 < 0 ? 0 : (d0 > 127 ? 127 : d0), i1 = d1 < 0 ? 0 : (d1 > 127 ? 127 : d1);
                    const float b0 = u.bias[i0], b1 = u.bias[i1];
                    p0[i] = ((lo >> bit) & 1u) ? p0[i] + b0 : -INFINITY; p1[i] = ((hw >> bit) & 1u) ? p1[i] + b1 : -INFINITY; }
            }
            float rm = fmaxf(p0[0], p1[0]);
#pragma unroll
            for (int i = 1; i < 16; ++i) rm = fmaxf(rm, fmaxf(p0[i], p1[i]));
            rm = fmaxf(rm, __shfl_xor(rm, 32));
            const float mn = fmaxf(m, rm); const float alpha = __builtin_amdgcn_exp2f(m - mn); m = mn;
            float rs = 0.f;
#pragma unroll
            for (int i = 0; i < 16; ++i) { p0[i] = __builtin_amdgcn_exp2f(p0[i] - mn); p1[i] = __builtin_amdgcn_exp2f(p1[i] - mn); rs += p0[i] + p1[i]; }
            l = l * alpha + rs;
#pragma unroll
            for (int i = 0; i < 16; ++i) { o0[i] *= alpha; o1[i] *= alpha; }
            u32x4 pw[4];
#pragma unroll
            for (int s = 0; s < 2; ++s) { pw[s] = (u32x4){cvtpk(p0[8 * s], p0[8 * s + 1]), cvtpk(p0[8 * s + 2], p0[8 * s + 3]), cvtpk(p0[8 * s + 4], p0[8 * s + 5]), cvtpk(p0[8 * s + 6], p0[8 * s + 7])};
                pw[2 + s] = (u32x4){cvtpk(p1[8 * s], p1[8 * s + 1]), cvtpk(p1[8 * s + 2], p1[8 * s + 3]), cvtpk(p1[8 * s + 4], p1[8 * s + 5]), cvtpk(p1[8 * s + 6], p1[8 * s + 7])}; }
            const ALAS unsigned char* vp = Kb + vbase;
#pragma unroll
            for (int s = 0; s < 4; ++s) {
                const s16x4 a0 = vtr(vp + s * 2048), a1 = vtr(vp + s * 2048 + 1024), c0 = vtr(vp + s * 2048 + 256), c1 = vtr(vp + s * 2048 + 1024 + 256);
                const bf16x8 vf0 = (bf16x8){a0[0], a0[1], a0[2], a0[3], a1[0], a1[1], a1[2], a1[3]}, vf1 = (bf16x8){c0[0], c0[1], c0[2], c0[3], c1[0], c1[1], c1[2], c1[3]};
                const bf16x8 pf = __builtin_bit_cast(bf16x8, pw[s]);
                o0 = __builtin_amdgcn_mfma_f32_32x32x16_bf16(vf0, pf, o0, 0, 0, 0);
                o1 = __builtin_amdgcn_mfma_f32_32x32x16_bf16(vf1, pf, o1, 0, 0, 0);
            }
        }
        if (more) AT_STORE(cur ^ 1);
        __syncthreads();
    }
#undef AT_LOAD
#undef AT_STORE
    l += __shfl_xor(l, 32);
    if (MODE == 1) l += __builtin_amdgcn_exp2f(u.sink2 - m);
    const float inv = 1.0f / l;
    bf16_t* op = u.O + (size_t)(u.tok0 + q) * u.ldo + 4 * hi;
#pragma unroll
    for (int g = 0; g < 4; ++g) {
        u32x2 w0 = {cvtpk(o0[4 * g] * inv, o0[4 * g + 1] * inv), cvtpk(o0[4 * g + 2] * inv, o0[4 * g + 3] * inv)};
        u32x2 w1 = {cvtpk(o1[4 * g] * inv, o1[4 * g + 1] * inv), cvtpk(o1[4 * g + 2] * inv, o1[4 * g + 3] * inv)};
        *(u32x2*)(op + 8 * g) = w0; *(u32x2*)(op + 32 + 8 * g) = w1;
    }
}

constexpr int SROW = 2052;
__device__ __forceinline__ void idx_unit(int b, int qb16, const bf16_t* PO, const float* WI, unsigned long long* BM, ALAS unsigned char* lds) {
    const int tid = threadIdx.x, lane = tid & 63, wave = __builtin_amdgcn_readfirstlane(tid >> 6), fr = lane & 15, fq = lane >> 4;
    const int t0 = qb16 * 16, tok0 = b * 2048, nk = t0 + 16, nt16 = qb16 + 1;
    ALAS float* S = (ALAS float*)lds;
    {
        bf16x8 qa[8]; const bf16_t* qp = PO + (size_t)(tok0 + t0 + fr) * 1536 + 768 + fq * 8;
#pragma unroll
        for (int h = 0; h < 8; ++h) qa[h] = *(const bf16x8*)(qp + h * 32);
        float wv[4][8];
#pragma unroll
        for (int i = 0; i < 4; ++i) { const f32x4 w0 = *(const f32x4*)(WI + (size_t)(tok0 + t0 + 4 * fq + i) * 8), w1 = *(const f32x4*)(WI + (size_t)(tok0 + t0 + 4 * fq + i) * 8 + 4);
#pragma unroll
            for (int e = 0; e < 4; ++e) { wv[i][e] = w0[e]; wv[i][4 + e] = w1[e]; } }
        for (int j = wave; j < nt16; j += 8) {
            const bf16x8 kf = *(const bf16x8*)(PO + (size_t)(tok0 + 16 * j + fr) * 1536 + 1280 + fq * 8);
            f32x4 sc = {0.f, 0.f, 0.f, 0.f};
#pragma unroll
            for (int h = 0; h < 8; ++h) { const f32x4 d = __builtin_amdgcn_mfma_f32_16x16x32_bf16(qa[h], kf, (f32x4){0.f, 0.f, 0.f, 0.f}, 0, 0, 0);
#pragma unroll
                for (int i = 0; i < 4; ++i) sc[i] += fmaxf(d[i], 0.f) * wv[i][h]; }
#pragma unroll
            for (int i = 0; i < 4; ++i) S[(4 * fq + i) * SROW + 16 * j + fr] = sc[i];
        }
    }
    __syncthreads();
    const int nreg = (nk + 63) >> 6;
#pragma unroll 1
    for (int rr = 0; rr < 2; ++rr) {
        const int r = 2 * wave + rr, t = t0 + r;
        unsigned uu[32];
#pragma unroll
        for (int i = 0; i < 32; ++i) { uu[i] = 0u;
            if (i < nreg) { const int key = 64 * i + lane; if (key <= t) { const unsigned bts = __float_as_uint(S[r * SROW + key]); uu[i] = (bts & 0x80000000u) ? ~bts : (bts | 0x80000000u); } } }
        unsigned long long myw = 0ull;
        if (t < 256) {
#pragma unroll
            for (int i = 0; i < 32; ++i) if (i < nreg) { const unsigned long long wd = __ballot(64 * i + lane <= t); if (lane == i) myw = wd; }
        } else {
            unsigned T = 0u;
#pragma unroll 1
            for (int bit = 31; bit >= 0; --bit) {
                const unsigned cand = T | (1u << bit); int c = 0;
#pragma unroll
                for (int i = 0; i < 32; ++i) if (i < nreg) c += __builtin_popcountll(__ballot(uu[i] >= cand));
                if (c >= 256) T = cand;
                if (c == 256) break;
            }
            int ngt = 0;
#pragma unroll
            for (int i = 0; i < 32; ++i) if (i < nreg) ngt += __builtin_popcountll(__ballot(uu[i] > T));
            int need = 256 - ngt;
#pragma unroll
            for (int i = 0; i < 32; ++i) if (i < nreg) {
                const unsigned long long gt = __ballot(uu[i] > T), eq = __ballot(uu[i] == T);
                const int rank = __builtin_amdgcn_mbcnt_hi((unsigned)(eq >> 32), __builtin_amdgcn_mbcnt_lo((unsigned)eq, 0u));
                const unsigned long long tk = __ballot((uu[i] == T) && (rank < need));
                need -= __builtin_popcountll(tk);
                const unsigned long long wd = gt | tk; if (lane == i) myw = wd; }
        }
        if (lane < 32) BM[(size_t)(tok0 + t) * 32 + lane] = myw;
    }
    __syncthreads();
}
#undef ALAS
}

constexpr int NWAVES = 8;
#ifndef MK_N_LAUNCHES
#define MK_N_LAUNCHES 13
#endif
constexpr int NPHASE = 13;
constexpr int N_LAUNCHES = MK_N_LAUNCHES;

constexpr int SEQ = 2048, NB = 16, M = NB * SEQ, D = 1024, FF = 4096;
constexpr int NE = 2304;
constexpr int NO = 1536;
constexpr float C2_64 = 0.125f * 1.4426950408889634f;
constexpr float C2_96 = 0.10206207261596577f * 1.4426950408889634f;

constexpr size_t MiB = 1u << 20;
constexpr size_t WS_CTL = 0, CTL_ZERO_BYTES = 64 * 1024;
constexpr size_t WS_ROPE = 1 * MiB;
constexpr size_t WS_BIAS = WS_ROPE + 256 * 1024;
constexpr size_t WS_FA = WS_BIAS + 64 * 1024;
constexpr size_t WS_F2 = WS_FA + 1 * MiB;
constexpr size_t WS_WI = WS_F2 + 1 * MiB;
constexpr size_t WS_SSQ = WS_WI + 1 * MiB;
constexpr size_t WS_SSKV = WS_SSQ + 512 * 1024;
constexpr size_t WS_SSA = 6 * MiB;
constexpr size_t WS_SSB = 8 * MiB;
constexpr size_t WS_W = 10 * MiB;
constexpr size_t W_INE = WS_W;
constexpr size_t W_OUTE = W_INE + (size_t)NE * D * 2;
constexpr size_t W_M1A = W_OUTE + (size_t)D * D * 2;
constexpr size_t W_M2A = W_M1A + (size_t)FF * D * 2;
constexpr size_t W_INO = W_M2A + (size_t)FF * D * 2;
constexpr size_t W_UQ = W_INO + (size_t)NO * D * 2;
constexpr size_t W_UKV = W_UQ + (size_t)768 * 256 * 2;
constexpr size_t W_OUTO = W_UKV + (size_t)1024 * 128 * 2;
constexpr size_t W_M1B = W_OUTO + (size_t)D * D * 2;
constexpr size_t W_M2B = W_M1B + (size_t)FF * D * 2;
constexpr size_t W_END = W_M2B + (size_t)FF * D * 2;
constexpr size_t WS_XB = 56 * MiB;
constexpr size_t WS_BIG = 120 * MiB;
constexpr size_t WS_PE = WS_BIG;
constexpr size_t WS_OE = WS_BIG + 144 * MiB;
constexpr size_t WS_H = WS_BIG;
constexpr size_t WS_PO = WS_BIG;
constexpr size_t WS_QD = WS_BIG + 96 * MiB;
constexpr size_t WS_KD = WS_BIG + 144 * MiB;
constexpr size_t WS_VD = WS_BIG + 192 * MiB;
constexpr size_t WS_OO = WS_BIG + 256 * MiB;
constexpr size_t WS_BM = WS_OO + 64 * MiB;
constexpr size_t WS_END = WS_BM + 8 * MiB;
static_assert(W_END <= WS_XB && WS_SSKV + 512 * 1024 <= WS_SSA, "d_ws map");
constexpr int CW_BAR = 1024;

constexpr int RING_BYTES = 131072;
constexpr int LDS_SCRATCH = 139264;
constexpr int LDSCTL_OFF = LDS_SCRATCH, MISC_OFF = LDSCTL_OFF + 320;
constexpr int LDS_BYTES = 147456;

#define GAS __attribute__((address_space(1)))
#define LAS __attribute__((address_space(3)))
typedef unsigned short bf16;
typedef unsigned v4u __attribute__((ext_vector_type(4)));
typedef float f32x4 __attribute__((ext_vector_type(4)));
typedef short bf16x8 __attribute__((ext_vector_type(8)));
typedef GAS unsigned gu32;
typedef GAS unsigned long long gu64;
#define RLX_AGENT __ATOMIC_RELAXED, __HIP_MEMORY_SCOPE_AGENT
#define LDS_WAIT() asm volatile("s_waitcnt lgkmcnt(0)" ::: "memory")
#define VM_WAIT() asm volatile("s_waitcnt vmcnt(0)" ::: "memory")
__device__ __forceinline__ unsigned long long rt() { return __builtin_amdgcn_s_memrealtime(); }
__device__ __forceinline__ unsigned f2bf(float f) { unsigned u = __builtin_bit_cast(unsigned, f); return (u + 0x7fffu + ((u >> 16) & 1u)) >> 16; }
__device__ __forceinline__ unsigned pk2(float lo, float hi) { return f2bf(lo) | (f2bf(hi) << 16); }

#define XB_TMO      128
#define XB_XCNT(j)  (256  + 64 * (j))
#define XB_XSUB(j)  (1280 + 64 * (j))
#define XB_XGEN(j)  (2304 + 64 * (j))
#define XB_TOP      3328
#define XB_TOPGEN   3392
#define XCD_BAR_WORDS 3456
#define XB_SPIN_CAP (1u << 18)

__device__ __forceinline__ unsigned xb_ld(unsigned* p)              { return __hip_atomic_load(p, __ATOMIC_RELAXED, __HIP_MEMORY_SCOPE_AGENT); }
__device__ __forceinline__ unsigned xb_add(unsigned* p, unsigned v) { return __hip_atomic_fetch_add(p, v, __ATOMIC_RELAXED, __HIP_MEMORY_SCOPE_AGENT); }
__device__ __forceinline__ unsigned xb_xcc_id() { return (unsigned)__builtin_amdgcn_s_getreg((3 << 11) | 20) & 0xFu; }
#define XB_SPIN(cond, bar) do { unsigned _sp = 0; while (cond) { __builtin_amdgcn_s_sleep(1); \
    if ((++_sp & 255u) == 0u) { if (xb_ld(&(bar)[XB_TMO])) break; if (_sp > XB_SPIN_CAP) { atomicAdd(&(bar)[XB_TMO], 1u); break; } } } } while (0)

struct XcdBarrier {
    unsigned* bar; unsigned x;
    volatile LAS unsigned* st;
};

__device__ __forceinline__ XcdBarrier xcd_barrier_post(unsigned* bar, volatile LAS unsigned* st) {
    XcdBarrier b; b.bar = bar; b.x = xb_xcc_id(); b.st = st;
    if (threadIdx.x == 0) (void)xb_add(&bar[XB_XCNT(b.x)], 1u);
    return b;
}
__device__ __forceinline__ void xcd_barrier_complete(unsigned* bar, unsigned x, unsigned& nloc, unsigned& nx) {
    const unsigned G = gridDim.x * gridDim.y * gridDim.z;
    unsigned sum, cnt, mine, sp = 0u;
    for (;;) {
        sum = 0u; cnt = 0u; mine = 0u;
#pragma unroll
        for (unsigned j = 0; j < 16; ++j) { const unsigned c = xb_ld(&bar[XB_XCNT(j)]); sum += c; cnt += (c > 0u) ? 1u : 0u; mine = (j == x) ? c : mine; }
        if (sum == G) break;
        __builtin_amdgcn_s_sleep(1);
        if ((++sp & 255u) == 0u) { if (xb_ld(&bar[XB_TMO])) break; if (sp > XB_SPIN_CAP) { atomicAdd(&bar[XB_TMO], 1u); break; } }
    }
    nloc = mine > 0u ? mine : 1u; nx = cnt > 0u ? cnt : 1u;
}

__device__ __forceinline__ void xcd_barrier(const XcdBarrier& b) {
    asm volatile("s_waitcnt vmcnt(0)" ::: "memory");
    __syncthreads();
    if (threadIdx.x == 0) {
        unsigned* bar = b.bar;
        __builtin_amdgcn_s_waitcnt(0);
        unsigned nloc = b.st[0], nx = b.st[1];
        if (nloc == 0u) { xcd_barrier_complete(bar, b.x, nloc, nx); b.st[0] = nloc; b.st[1] = nx; }
        const unsigned old = xb_add(&bar[XB_XSUB(b.x)], 1u);
        const unsigned gen = old / nloc;
        if (old + 1u == (gen + 1u) * nloc) {
            __builtin_amdgcn_fence(__ATOMIC_RELEASE, "agent");
            asm volatile("s_waitcnt vmcnt(0)" ::: "memory");
            const unsigned og = xb_add(&bar[XB_TOP], 1u);
            const unsigned tg = og / nx;
            if (og + 1u == (tg + 1u) * nx) xb_add(&bar[XB_TOPGEN], 1u);
            else XB_SPIN(xb_ld(&bar[XB_TOPGEN]) == tg, bar);
            __builtin_amdgcn_fence(__ATOMIC_ACQUIRE, "agent");
            xb_add(&bar[XB_XGEN(b.x)], 1u);
            asm volatile("s_waitcnt vmcnt(0)" ::: "memory");
        } else {
            XB_SPIN(xb_ld(&bar[XB_XGEN(b.x)]) == gen, bar);
            __builtin_amdgcn_fence(__ATOMIC_ACQUIRE, "agent");
            asm volatile("s_waitcnt vmcnt(0)" ::: "memory");
        }
    }
    __syncthreads();
}

__device__ __forceinline__ float wave_sum(float v) {
#pragma unroll
    for (int o = 1; o < 64; o <<= 1) v += __shfl_xor(v, o);
    return v;
}
template <int WHICH> __device__ __forceinline__ int srccol(int n) {
    if (WHICH == 0) return n;
    if (WHICH == 1) return n < 1536 ? n : n + 8;
    if (n < 512) return n;
    if (n < 768) return 936 + (n - 512);
    if (n < 1024) return 640 + (n - 768);
    if (n < 1152) return 1192 + (n - 1024);
    if (n < 1216) return 512 + (n - 1152);
    if (n < 1280) return 576 + (n - 1216);
    if (n < 1312) return 896 + (n - 1280);
    if (n < 1344) return 1320 + (n - 1312);
    if (n < 1352) return 928 + (n - 1344);
    return -1;
}
template <int WHICH>
__device__ __forceinline__ void p0_transpose_item(const float* W, int K, int Nsrc, int Ndst, const float* gain, bf16* WT, LAS float* scr, int item, int lane) {
    const int nblk = Ndst / 32, kb = item / nblk, nb = item % nblk, k0 = 64 * kb, n0 = 32 * nb;
    const int sc = srccol<WHICH>(n0 + (lane & 31));
#pragma unroll 8
    for (int i = 0; i < 32; ++i) { const int kk = 2 * i + (lane >> 5); float v = 0.f; if (sc >= 0) { v = W[(size_t)(k0 + kk) * Nsrc + sc]; if (gain) v *= gain[k0 + kk]; } scr[kk * 33 + (lane & 31)] = v; }
    LDS_WAIT(); asm volatile("" ::: "memory");
    const int c = lane & 7;
#pragma unroll
    for (int j = 0; j < 4; ++j) { const int n = (lane >> 3) + 8 * j; const LAS float* s = scr + (8 * c) * 33 + n;
        v4u o; o.x = pk2(s[0 * 33], s[1 * 33]); o.y = pk2(s[2 * 33], s[3 * 33]); o.z = pk2(s[4 * 33], s[5 * 33]); o.w = pk2(s[6 * 33], s[7 * 33]);
        *(GAS v4u*)(WT + (size_t)(n0 + n) * K + k0 + 8 * c) = o; }
    LDS_WAIT(); asm volatile("" ::: "memory");
}
__device__ __forceinline__ int t5_bucket(int n) {
    if (n < 16) return n;
    const float nf = (float)n; int large = 16 + (int)(logf(fmaxf(nf, 16.f) / 16.f) / logf(8.f) * 16.f);
    return large < 31 ? large : 31;
}

struct Args { const float* in[18]; float* out; unsigned char* ws; int ph_lo, ph_hi, li, pad; };
__global__ void __launch_bounds__(NWAVES * 64, 2) fwd_kernel(Args args) {
    extern __shared__ __attribute__((aligned(16))) unsigned char lds_raw[];
    LAS unsigned char* lds = (LAS unsigned char*)lds_raw;
    volatile LAS unsigned* MISC = (volatile LAS unsigned*)(lds + MISC_OFF);
    const int tid = threadIdx.x, lane = tid & 63, wave = __builtin_amdgcn_readfirstlane(tid >> 6);
    const int G = gridDim.x, bx = blockIdx.x, vcu = (G % 8 == 0) ? (bx % 8) * (G / 8) + bx / 8 : bx;
    unsigned char* ws = args.ws;
    gu32* ctl = (gu32*)(ws + WS_CTL);
    const float* x_in = args.in[0];
    float* out = args.out;
    bf16* XB = (bf16*)(ws + WS_XB); bf16* PE = (bf16*)(ws + WS_PE); bf16* OE = (bf16*)(ws + WS_OE); bf16* HB = (bf16*)(ws + WS_H);
    bf16* PO = (bf16*)(ws + WS_PO); bf16* QD = (bf16*)(ws + WS_QD); bf16* KD = (bf16*)(ws + WS_KD); bf16* VD = (bf16*)(ws + WS_VD); bf16* OO = (bf16*)(ws + WS_OO);
    unsigned long long* BMg = (unsigned long long*)(ws + WS_BM);
    float* ROPE = (float*)(ws + WS_ROPE); float* BIAS = (float*)(ws + WS_BIAS); float* FA = (float*)(ws + WS_FA); float* F2 = (float*)(ws + WS_F2); float* WI = (float*)(ws + WS_WI);
    float* SSQ = (float*)(ws + WS_SSQ); float* SSKV = (float*)(ws + WS_SSKV); float* SSA = (float*)(ws + WS_SSA); float* SSB = (float*)(ws + WS_SSB);

    for (int u = tid; u < (LDS_BYTES - LDSCTL_OFF) / 4; u += NWAVES * 64) ((LAS unsigned*)(lds + LDSCTL_OFF))[u] = 0u;
    __syncthreads();
    XcdBarrier bar; bar.bar = (unsigned*)(ctl + CW_BAR); bar.x = 0; bar.st = nullptr;
    if (N_LAUNCHES == 1) bar = xcd_barrier_post((unsigned*)(ctl + CW_BAR), MISC + 8);
#define GRID_BAR() do { if (N_LAUNCHES == 1) xcd_barrier(bar); } while (0)
    const int lo = args.ph_lo, hi = args.ph_hi;
#ifndef PH_MASK
#define PH_MASK 0x1FFF
#endif
#define IN(k) ((((PH_MASK) >> (k)) & 1) && lo <= (k) && (k) < hi)
#define SEAM(k) do { if (IN(k) && IN((k) + 1)) GRID_BAR(); } while (0)

    if (IN(0)) {
        LAS float* scr = (LAS float*)(lds + wave * 16384);
        const int gw = vcu * NWAVES + wave, NGW = G * NWAVES;
        const float* nmE = args.in[1]; const float* winE = args.in[2]; const float* woutE = args.in[5]; const float* nmO = args.in[6]; const float* winO = args.in[7];
        const float* ncq = args.in[8]; const float* nckv = args.in[9]; const float* wuq = args.in[10]; const float* wukv = args.in[11]; const float* woutO = args.in[12];
        const float* nmlp = args.in[13]; const float* w1 = args.in[14]; const float* w2 = args.in[15];
        constexpr int I0 = 16 * 72, I1 = 16 * 32, I2 = 16 * 128, I3 = 64 * 32, I4 = 16 * 48, I5 = 4 * 24, I6 = 2 * 32;
        constexpr int NITEMS = I0 + I1 + I2 + I3 + I4 + I5 + I6 + I1 + I2 + I3;
        for (int it = gw; it < NITEMS; it += NGW) {
            int r = it;
            if (r < I0) { p0_transpose_item<1>(winE, 1024, 2312, NE, nmE, (bf16*)(ws + W_INE), scr, r, lane); continue; } r -= I0;
            if (r < I1) { p0_transpose_item<0>(woutE, 1024, 1024, 1024, nullptr, (bf16*)(ws + W_OUTE), scr, r, lane); continue; } r -= I1;
            if (r < I2) { p0_transpose_item<0>(w1, 1024, 4096, 4096, nmlp, (bf16*)(ws + W_M1A), scr, r, lane); continue; } r -= I2;
            if (r < I3) { p0_transpose_item<0>(w2, 4096, 1024, 1024, nullptr, (bf16*)(ws + W_M2A), scr, r, lane); continue; } r -= I3;
            if (r < I4) { p0_transpose_item<2>(winO, 1024, 1352, NO, nmO, (bf16*)(ws + W_INO), scr, r, lane); continue; } r -= I4;
            if (r < I5) { p0_transpose_item<0>(wuq, 256, 768, 768, ncq, (bf16*)(ws + W_UQ), scr, r, lane); continue; } r -= I5;
            if (r < I6) { p0_transpose_item<0>(wukv, 128, 1024, 1024, nckv, (bf16*)(ws + W_UKV), scr, r, lane); continue; } r -= I6;
            if (r < I1) { p0_transpose_item<0>(woutO, 1024, 1024, 1024, nullptr, (bf16*)(ws + W_OUTO), scr, r, lane); continue; } r -= I1;
            if (r < I2) { p0_transpose_item<0>(w1 + (size_t)1024 * 4096, 1024, 4096, 4096, nmlp + 1024, (bf16*)(ws + W_M1B), scr, r, lane); continue; } r -= I2;
            p0_transpose_item<0>(w2 + (size_t)4096 * 1024, 4096, 1024, 1024, nullptr, (bf16*)(ws + W_M2B), scr, r, lane);
        }
        { const int gt = vcu * (NWAVES * 64) + tid;
          if (gt < 2048 * 16) { const int pos = gt >> 4, i = gt & 15; const float inv = powf(10000.0f, -(float)(2 * i) / 32.0f); const float ang = (float)pos * inv; float sn, cs; sincosf(ang, &sn, &cs); ROPE[2 * gt] = cs; ROPE[2 * gt + 1] = sn; }
          if (gt < 2048) { const int which = gt >> 10, h = (gt >> 7) & 7, d = gt & 127; BIAS[gt] = args.in[16][t5_bucket(d) * 16 + which * 8 + h] * att::LOG2E; } }
        { float wf[16][8];
#pragma unroll
          for (int j = 0; j < 4; ++j)
#pragma unroll
              for (int e = 0; e < 4; ++e) { const int k = 256 * j + 4 * lane + e; const float gk = nmE[k];
#pragma unroll
                  for (int c = 0; c < 8; ++c) wf[j * 4 + e][c] = winE[(size_t)k * 2312 + 1536 + c] * gk; }
          for (int m = gw; m < M; m += NGW) {
              const GAS f32x4* xr = (const GAS f32x4*)(x_in + (size_t)m * D) + lane; f32x4 v[4]; float ss = 0.f;
#pragma unroll
              for (int j = 0; j < 4; ++j) { v[j] = xr[64 * j]; ss += (v[j].x * v[j].x + v[j].y * v[j].y) + (v[j].z * v[j].z + v[j].w * v[j].w); }
              ss = wave_sum(ss);
              GAS unsigned long long* o8 = (GAS unsigned long long*)(XB + (size_t)m * D) + lane;
#pragma unroll
              for (int j = 0; j < 4; ++j) o8[64 * j] = (unsigned long long)pk2(v[j].x, v[j].y) | ((unsigned long long)pk2(v[j].z, v[j].w) << 32);
              float dt[8];
#pragma unroll
              for (int c = 0; c < 8; ++c) { float a = 0.f;
#pragma unroll
                  for (int j = 0; j < 4; ++j) a += (v[j].x * wf[j * 4][c] + v[j].y * wf[j * 4 + 1][c]) + (v[j].z * wf[j * 4 + 2][c] + v[j].w * wf[j * 4 + 3][c]);
                  dt[c] = wave_sum(a); }
              const float rstd = 1.0f / sqrtf(ss * (1.0f / 1024.0f) + 1e-6f);
              float mine = 0.f;
#pragma unroll
              for (int c = 0; c < 8; ++c) if (lane == c) mine = dt[c] * rstd;
              if (lane < 8) FA[(size_t)m * 8 + lane] = mine;
              if (lane < 16) SSA[(size_t)m * 16 + lane] = (lane == 0) ? ss : 0.f;
          } }
    }
    SEAM(0);
    if (IN(1)) {
        if (bx < 16) {
            const int b = bx, h = wave; const float bf = args.in[3][h]; float pre[32]; float run = 0.f;
#pragma unroll
            for (int i = 0; i < 32; ++i) { const float f = FA[(size_t)(b * SEQ + 32 * lane + i) * 8 + h] + bf; const float ls = fminf(f, 0.f) - log1pf(expf(-fabsf(f))); run += ls; pre[i] = run; }
            float incl = run;
#pragma unroll
            for (int o = 1; o < 64; o <<= 1) { const float t = __shfl_up(incl, o); if (lane >= o) incl += t; }
            const float excl = incl - run; float* dst = F2 + (size_t)(b * 8 + h) * SEQ + 32 * lane;
#pragma unroll
            for (int i = 0; i < 32; ++i) dst[i] = (excl + pre[i]) * att::LOG2E;
        }
        pg8::Gemm g{XB, (const bf16*)(ws + W_INE), M, NE, D, D}; pg8::StaticOrder S; S.init(M, NE, G, bx);
        pg8::EpiNormBf16<0> E{PE, NE, SSA, 0xC3u, C2_64};
        pg8::gemm_phase<pg8::EpiNormBf16<0>, pg8::StaticOrder, true, true>(lds, g, S, E);
    }
    SEAM(1);
    if (IN(2)) {
        for (int i = tid; i < 2048; i += NWAVES * 64) ((LAS float*)(lds + att::BIAS_LDS_OFF))[i] = BIAS[i];
        __syncthreads();
        for (int p = vcu; p < 512; p += G) { const int bh = p >> 2, s = p & 3, b = bh >> 3, h = bh & 7;
            for (int z = 0; z < 2; ++z) { const int qb = z ? s : 7 - s;
                att::AU u; u.Q = PE + h * 64; u.ldq = NE; u.K = PE + 512 + h * 64; u.ldk = NE; u.V = PE + 1024 + h * 64; u.ldv = NE; u.O = OE + h * 64; u.ldo = D;
                u.tok0 = b * SEQ; u.qpos = qb * 256 + wave * 32; u.t_lo = 0; u.t_hi = qb * 4 + 4; u.F2 = F2 + (size_t)(b * 8 + h) * SEQ; u.cb = u.F2[qb * 256];
                u.bias = nullptr; u.sink2 = 0.f; u.bm = nullptr;
                att::attn_unit<64, 0>(u, lds); } }
        for (int idx = vcu; idx < 1024; idx += G) { const int half = idx & 1, n = (idx >> 1) & 15, kvh = (idx >> 5) & 1, b = idx >> 6;
            const int hq = kvh * 4 + half * 2 + (wave >> 2);
            att::AU u; u.Q = PE + 1536 + hq * 64; u.ldq = NE; u.K = PE + 2048 + kvh * 64; u.ldk = NE; u.V = PE + 2176 + kvh * 64; u.ldv = NE; u.O = OE + 512 + hq * 64; u.ldo = D;
            u.tok0 = b * SEQ; u.qpos = n * 128 + (wave & 3) * 32; u.t_lo = n > 0 ? 2 * n - 2 : 0; u.t_hi = 2 * n + 2; u.F2 = nullptr; u.cb = 0.f;
            u.bias = (const LAS float*)(lds + att::BIAS_LDS_OFF) + hq * 128; u.sink2 = args.in[4][hq] * att::LOG2E; u.bm = nullptr;
            att::attn_unit<64, 1>(u, lds); }
    }
    SEAM(2);
    if (IN(3)) {
        pg8::Gemm g{OE, (const bf16*)(ws + W_OUTE), M, D, D, D}; pg8::StaticOrder S; S.init(M, D, G, bx);
        pg8::EpiResid<true> E{x_in, out, XB, SSB};
        pg8::gemm_phase<pg8::EpiResid<true>, pg8::StaticOrder, true, true>(lds, g, S, E);
    }
    SEAM(3);
    if (IN(4)) {
        pg8::Gemm g{XB, (const bf16*)(ws + W_M1A), M, FF, D, D}; pg8::StaticOrder S; S.init(M, FF, G, bx);
        pg8::EpiNormBf16<1> E{HB, FF, SSB, 0u, 1.f};
        pg8::gemm_phase<pg8::EpiNormBf16<1>, pg8::StaticOrder, true, true>(lds, g, S, E);
    }
    SEAM(4);
    if (IN(5)) {
        pg8::Gemm g{HB, (const bf16*)(ws + W_M2A), M, D, FF, FF}; pg8::StaticOrder S; S.init(M, D, G, bx);
        pg8::EpiResid<true> E{out, out, XB, SSA};
        pg8::gemm_phase<pg8::EpiResid<true>, pg8::StaticOrder, true, true>(lds, g, S, E);
    }
    SEAM(5);
    if (IN(6)) {
        pg8::Gemm g{XB, (const bf16*)(ws + W_INO), M, NO, D, D}; pg8::StaticOrder S; S.init(M, NO, G, bx);
        pg8::EpiInOdd E{PO, SSA, C2_64, SSQ, SSKV, KD, WI, ROPE};
        pg8::gemm_phase<pg8::EpiInOdd, pg8::StaticOrder, true, true>(lds, g, S, E);
    }
    SEAM(6);
    if (IN(7)) {
        { int kq_ = 256; asm volatile("" : "+s"(kq_)); pg8::Gemm g{PO + 512, (const bf16*)(ws + W_UQ), M, 768, kq_, NO}; pg8::StaticOrder S; S.init(M, 768, G, bx);
          pg8::EpiUq E{QD, SSQ, C2_96, ROPE};
          pg8::gemm_phase<pg8::EpiUq, pg8::StaticOrder, true, true>(lds, g, S, E); }
        { int kk_ = 128; asm volatile("" : "+s"(kk_)); pg8::Gemm g{PO + 1024, (const bf16*)(ws + W_UKV), M, 1024, kk_, NO}; pg8::StaticOrder S; S.init(M, 1024, G, bx);
          pg8::EpiUkv E{KD, VD, SSKV};
          pg8::gemm_phase<pg8::EpiUkv, pg8::StaticOrder, true, true>(lds, g, S, E); }
        __syncthreads();
        for (int ui = vcu; ui < 2048; ui += G) { const int k = ui >> 8, v = ui & 255, b = 2 * k + (v >> 7), qb16 = (k & 1) ? 127 - (v & 127) : (v & 127);
            att::idx_unit(b, qb16, PO, WI, BMg, lds); }
    }
    SEAM(7);
    if (IN(8)) {
        for (int i = tid; i < 2048; i += NWAVES * 64) ((LAS float*)(lds + att::BIAS_LDS_OFF))[i] = BIAS[i];
        __syncthreads();
        for (int p = vcu; p < 512; p += G) { const int b = p >> 5, jp = p & 31;
            for (int z = 0; z < 2; ++z) { const int j = z ? jp : 63 - jp; const int hq = wave;
                att::AU u; u.Q = PO + hq * 64; u.ldq = NO; u.K = PO + 1152; u.ldk = NO; u.V = PO + 1216; u.ldv = NO; u.O = OO + hq * 64; u.ldo = D;
                u.tok0 = b * SEQ; u.qpos = 32 * j; u.t_lo = 0; u.t_hi = (j >> 1) + 1; u.F2 = nullptr; u.cb = 0.f;
                u.bias = (const LAS float*)(lds + att::BIAS_LDS_OFF) + 1024 + hq * 128; u.sink2 = 0.f; u.bm = BMg + (size_t)b * SEQ * 32;
                att::attn_unit<64, 2>(u, lds); } }
        for (int p = vcu; p < 512; p += G) { const int bh = p >> 2, s = p & 3, b = bh >> 3, h = bh & 7;
            for (int z = 0; z < 2; ++z) { const int qb = z ? s : 7 - s;
                att::AU u; u.Q = QD + h * 96; u.ldq = 768; u.K = KD + h * 96; u.ldk = 768; u.V = VD + h * 64; u.ldv = 512; u.O = OO + 512 + h * 64; u.ldo = D;
                u.tok0 = b * SEQ; u.qpos = qb * 256 + wave * 32; u.t_lo = 0; u.t_hi = qb * 4 + 4; u.F2 = nullptr; u.cb = 0.f; u.bias = nullptr; u.sink2 = 0.f; u.bm = nullptr;
                att::attn_unit<96, 3>(u, lds); } }
    }
    SEAM(8);
    if (IN(9)) {
        pg8::Gemm g{OO, (const bf16*)(ws + W_OUTO), M, D, D, D}; pg8::StaticOrder S; S.init(M, D, G, bx);
        pg8::EpiResid<true> E{out, out, XB, SSB};
        pg8::gemm_phase<pg8::EpiResid<true>, pg8::StaticOrder, true, true>(lds, g, S, E);
    }
    SEAM(9);
    if (IN(10)) {
        pg8::Gemm g{XB, (const bf16*)(ws + W_M1B), M, FF, D, D}; pg8::StaticOrder S; S.init(M, FF, G, bx);
        pg8::EpiNormBf16<1> E{HB, FF, SSB, 0u, 1.f};
        pg8::gemm_phase<pg8::EpiNormBf16<1>, pg8::StaticOrder, true, true>(lds, g, S, E);
    }
    SEAM(10);
    if (IN(11)) {
        pg8::Gemm g{HB, (const bf16*)(ws + W_M2B), M, D, FF, FF}; pg8::StaticOrder S; S.init(M, D, G, bx);
        pg8::EpiResid<false> E{out, out, XB, SSA};
        pg8::gemm_phase<pg8::EpiResid<false>, pg8::StaticOrder, true, true>(lds, g, S, E);
    }
    SEAM(11);
    if (IN(12)) {
        const int gw = vcu * NWAVES + wave, NGW = G * NWAVES; const float* gf = args.in[17];
        f32x4 gv[4];
#pragma unroll
        for (int j = 0; j < 4; ++j) gv[j] = *((const f32x4*)gf + lane + 64 * j);
        for (int m = gw; m < M; m += NGW) {
            float s = (lane < 16) ? SSA[(size_t)m * 16 + lane] : 0.f; s = wave_sum(s);
            const float rstd = 1.0f / sqrtf(s * (1.0f / 1024.0f) + 1e-6f);
            GAS f32x4* xr = (GAS f32x4*)(out + (size_t)m * D) + lane;
#pragma unroll
            for (int j = 0; j < 4; ++j) { f32x4 v = xr[64 * j]; v = v * rstd * gv[j]; xr[64 * j] = v; }
        }
    }
#undef IN
#undef SEAM
#undef GRID_BAR
}

extern "C" void kernel_launch(void* const* d_in, const int* in_sizes, int n_in, void* d_out, int out_size, void* d_ws, size_t ws_size, hipStream_t stream) {
    static int grid = 0;
    if (grid == 0) {
        if (n_in != 18 || in_sizes[0] != M * D || out_size != M * D || ws_size < WS_END) { fprintf(stderr, "kernel_launch: shape/workspace mismatch: n_in %d in0 %d out %d ws %zu (need %zu)\n", n_in, n_in > 0 ? in_sizes[0] : -1, out_size, ws_size, (size_t)WS_END); grid = -1; return; }
        int dev = 0, cus = 0, per_cu = 0;
        if (hipGetDevice(&dev) != hipSuccess || hipDeviceGetAttribute(&cus, hipDeviceAttributeMultiprocessorCount, dev) != hipSuccess) { fprintf(stderr, "kernel_launch: device query failed\n"); grid = -1; return; }
        if (hipFuncSetAttribute((const void*)fwd_kernel, hipFuncAttributeMaxDynamicSharedMemorySize, LDS_BYTES) != hipSuccess) { fprintf(stderr, "kernel_launch: hipFuncSetAttribute failed\n"); grid = -1; return; }
        if (hipOccupancyMaxActiveBlocksPerMultiprocessor(&per_cu, (const void*)fwd_kernel, NWAVES * 64, LDS_BYTES) != hipSuccess || per_cu < 1) { fprintf(stderr, "kernel_launch: occupancy query reports %d blocks per CU\n", per_cu); (void)hipGetLastError(); per_cu = 1; }
        grid = cus;
    }
    if (grid < 0) return;
    if (hipMemsetAsync((char*)d_ws + WS_CTL, 0, CTL_ZERO_BYTES, stream) != hipSuccess) { fprintf(stderr, "kernel_launch: memset failed\n"); return; }
    Args a{};
    for (int i = 0; i < 18; ++i) a.in[i] = (const float*)d_in[i];
    a.out = (float*)d_out; a.ws = (unsigned char*)d_ws;
    for (int li = 0; li < N_LAUNCHES; ++li) {
        a.ph_lo = (N_LAUNCHES == 1) ? 0 : li; a.ph_hi = (N_LAUNCHES == 1) ? NPHASE : li + 1; a.li = li;
        hipLaunchKernelGGL(fwd_kernel, dim3(grid), dim3(NWAVES * 64), LDS_BYTES, stream, a);
        const hipError_t le = hipPeekAtLastError();
        if (le != hipSuccess) { fprintf(stderr, "kernel_launch: launch %d failed: %s\n", li, hipGetErrorName(le)); break; }
    }
}
```

```cpp
#include <hip/hip_runtime.h>
#include <hip/hip_bf16.h>
#include <cstdio>
#include <cstdint>
#include <cmath>
namespace pg8 {
#define PG8_LAS __attribute__((address_space(3)))
typedef unsigned short bf16_t;
typedef short bf16x8 __attribute__((ext_vector_type(8)));
typedef float f32x4 __attribute__((ext_vector_type(4)));
typedef unsigned u32x4 __attribute__((ext_vector_type(4)));
constexpr int BM = 256, BK = 64, HALF = 128, HTB = HALF * BK * 2  , STAGE_BYTES = 8 * HTB, NXCD = 8, WGM = 8;

__host__ __device__ __forceinline__ int lds_byte(int r, int c) { const int st = (r >> 4) * 2 + (c >> 5), rr = r & 15, cc = c & 31, ob = rr * 64 + cc * 2; return st * 1024 + (ob ^ (((ob >> 9) & 1) << 5)); }
__host__ __device__ __forceinline__ void stage_rc(int b, int& R, int& C) { const int st = b / 1024, sb = b % 1024, swz = sb ^ (((sb >> 9) & 1) << 5); R = (st >> 1) * 16 + swz / 64; C = (st & 1) * 32 + (swz % 64) / 2; }
__host__ __device__ __forceinline__ int perm32(int rho) { const int n = rho >> 4, i = rho & 15; return 8 * (i >> 2) + 4 * n + (i & 3); }

struct Unit { int pm, pn; };
struct Gemm { const bf16_t* A; const bf16_t* Bt; int M, N, K, lda; };

struct StaticOrder {
    int nM, nN, nwg, G, c;
    __host__ __device__ void init(int M, int N, int G_, int c_) { nM = M / BM; nN = N / BM; nwg = nM * nN; G = G_; c = c_; }
    __host__ __device__ bool next(int i, Unit& u) const {
        const long L = (long)i * G + c; if (L >= nwg) return false;
        int wgid = (int)L; { const int q = nwg / NXCD, r = nwg % NXCD, xcd = wgid % NXCD, off = wgid / NXCD; wgid = (xcd < r ? xcd * (q + 1) : r * (q + 1) + (xcd - r) * q) + off; }
        const int nig = WGM * nN, gid = wgid / nig, fm = gid * WGM, gsz = (nM - fm) < WGM ? (nM - fm) : WGM;
        u.pm = fm + ((wgid % nig) % gsz); u.pn = (wgid % nig) / gsz; return true;
    }
    __device__ __forceinline__ void a_ready(const Unit&) const {}
    __device__ __forceinline__ void done(const Unit&) const {}
};


typedef unsigned u32x2 __attribute__((ext_vector_type(2)));
typedef float f32x2e __attribute__((ext_vector_type(2)));
typedef __bf16 bf16x2e __attribute__((ext_vector_type(2)));
__device__ __forceinline__ unsigned cvt2(float lo, float hi) { f32x2e v = {lo, hi}; bf16x2e b = __builtin_convertvector(v, bf16x2e); return __builtin_bit_cast(unsigned, b); }
__device__ __forceinline__ u32x4 pack8(const f32x4 a, const f32x4 b) { u32x4 w; w.x = cvt2(a[0], a[1]); w.y = cvt2(a[2], a[3]); w.z = cvt2(b[0], b[1]); w.w = cvt2(b[2], b[3]); return w; }
constexpr float RMS_EPS = 1e-6f;
__device__ __forceinline__ float row_rstd16(const float* ssP, int row, int fq, float invn) {
    const f32x4 p = *(const f32x4*)(ssP + (size_t)row * 16 + 4 * fq); float s = (p[0] + p[1]) + (p[2] + p[3]);
    s += __shfl_xor(s, 16); s += __shfl_xor(s, 32); return 1.0f / sqrtf(s * invn + RMS_EPS);
}
__device__ __forceinline__ float row_rstd4(const float* ssP, int row, int fq, float invn) {
    float s = ssP[(size_t)row * 4 + fq]; s += __shfl_xor(s, 16); s += __shfl_xor(s, 32); return 1.0f / sqrtf(s * invn + RMS_EPS);
}
__device__ __forceinline__ float sq8(const f32x4 a, const f32x4 b) { return ((a[0] * a[0] + a[1] * a[1]) + (a[2] * a[2] + a[3] * a[3])) + ((b[0] * b[0] + b[1] * b[1]) + (b[2] * b[2] + b[3] * b[3])); }

template <int ACT> struct EpiNormBf16 {
    static constexpr bool PERM = true, AFTER_DRAIN = false;
    bf16_t* O; int ldc; const float* ssP; unsigned qmask; float qscale;
    __device__ __forceinline__ void operator()(const f32x4 (&acc)[2][2][4][2], const Unit& u, int wr, int wc, int fr, int fq) const {
        const int row0 = u.pm * BM + wr * 64 + fr, col0 = u.pn * BM + wc * 32 + 8 * fq;
        const float ts = ((qmask >> u.pn) & 1u) ? qscale : 1.f;
#pragma unroll
        for (int ai = 0; ai < 2; ++ai)
#pragma unroll
            for (int m = 0; m < 4; ++m) { const int row = row0 + ai * HALF + m * 16; const float rs = row_rstd16(ssP, row, fq, 1.0f / 1024.0f) * ts;
                bf16_t* rowp = O + (size_t)row * ldc + col0;
#pragma unroll
                for (int bj = 0; bj < 2; ++bj) { f32x4 v0 = acc[ai][bj][m][0] * rs, v1 = acc[ai][bj][m][1] * rs;
                    if (ACT == 1) {
#pragma unroll
                        for (int e = 0; e < 4; ++e) { const float a = fmaxf(v0[e], 0.f), b = fmaxf(v1[e], 0.f); v0[e] = a * a; v1[e] = b * b; } }
                    *(u32x4*)(rowp + bj * HALF) = pack8(v0, v1); } }
    }
};
struct EpiResid {
    static constexpr bool PERM = true, AFTER_DRAIN = false;
    const bf16_t* xb; bf16_t* xout; float* ssOut;
    __device__ __forceinline__ void operator()(const f32x4 (&acc)[2][2][4][2], const Unit& u, int wr, int wc, int fr, int fq) const {
        const int row0 = u.pm * BM + wr * 64 + fr, col0 = u.pn * BM + wc * 32 + 8 * fq;
#pragma unroll
        for (int ai = 0; ai < 2; ++ai)
#pragma unroll
            for (int m = 0; m < 4; ++m) { const int row = row0 + ai * HALF + m * 16; const size_t off = (size_t)row * 1024 + col0; float s = 0.f;
#pragma unroll
                for (int bj = 0; bj < 2; ++bj) { const u32x4 r = *(const u32x4*)(xb + off + bj * HALF);
                    const f32x4 r0 = {__uint_as_float(r.x << 16), __uint_as_float(r.x & 0xFFFF0000u), __uint_as_float(r.y << 16), __uint_as_float(r.y & 0xFFFF0000u)};
                    const f32x4 r1 = {__uint_as_float(r.z << 16), __uint_as_float(r.z & 0xFFFF0000u), __uint_as_float(r.w << 16), __uint_as_float(r.w & 0xFFFF0000u)};
                    const f32x4 v0 = acc[ai][bj][m][0] + r0, v1 = acc[ai][bj][m][1] + r1;
                    *(u32x4*)(xout + off + bj * HALF) = pack8(v0, v1);
                    s += sq8(v0, v1); }
                s += __shfl_xor(s, 16); s += __shfl_xor(s, 32);
                if (fq == 0) ssOut[(size_t)row * 16 + u.pn * 4 + wc] = s; }
    }
};
struct EpiInOdd {
    static constexpr bool PERM = true, AFTER_DRAIN = false;
    bf16_t* PO; const float* ssP; float qscale; float* ssq; float* sskv; bf16_t* Kd; float* WI; const float* rope;
    __device__ __forceinline__ void operator()(const f32x4 (&acc)[2][2][4][2], const Unit& u, int wr, int wc, int fr, int fq) const {
        const int row0 = u.pm * BM + wr * 64 + fr, col0 = u.pn * BM + wc * 32 + 8 * fq;
        const float ts = (u.pn < 2) ? qscale : 1.f;
#pragma unroll
        for (int ai = 0; ai < 2; ++ai)
#pragma unroll
            for (int m = 0; m < 4; ++m) { const int row = row0 + ai * HALF + m * 16; const float rs = row_rstd16(ssP, row, fq, 1.0f / 1024.0f) * ts;
                bf16_t* rowp = PO + (size_t)row * 1536 + col0;
                const f32x4 a0 = acc[ai][0][m][0] * rs, a1 = acc[ai][0][m][1] * rs, b0 = acc[ai][1][m][0] * rs, b1 = acc[ai][1][m][1] * rs;
                *(u32x4*)(rowp) = pack8(a0, a1); *(u32x4*)(rowp + HALF) = pack8(b0, b1);
                if (u.pn == 2) { float s = sq8(a0, a1) + sq8(b0, b1); s += __shfl_xor(s, 16); s += __shfl_xor(s, 32); if (fq == 0) ssq[(size_t)row * 4 + wc] = s; }
                if (u.pn == 4) { float s = sq8(a0, a1); s += __shfl_xor(s, 16); s += __shfl_xor(s, 32); if (fq == 0) sskv[(size_t)row * 4 + wc] = s; }
                if (u.pn == 5) {
                    if (wc == 1) {
                        const int pos = row & 2047, i0 = 8 * (fq & 1); const float* rp = rope + ((size_t)pos * 16 + i0) * 2;
                        f32x4 o0, o1;
#pragma unroll
                        for (int e = 0; e < 8; ++e) { const float v = e < 4 ? a0[e] : a1[e - 4]; const float w = __shfl_xor(v, 32); const float c = rp[2 * e], sn = rp[2 * e + 1];
                            const float o = (fq < 2) ? (v * c - w * sn) : (w * sn + v * c); if (e < 4) o0[e] = o; else o1[e - 4] = o; }
                        const u32x4 pk = pack8(o0, o1);
#pragma unroll
                        for (int h = 0; h < 8; ++h) *(u32x4*)(Kd + (size_t)row * 768 + h * 96 + 64 + 8 * fq) = pk;
                    }
                    if (wc == 2 && fq == 0) { *(f32x4*)(WI + (size_t)row * 8) = a0; *(f32x4*)(WI + (size_t)row * 8 + 4) = a1; }
                } }
    }
};
struct EpiUq {
    static constexpr bool PERM = true, AFTER_DRAIN = false;
    bf16_t* Qd; const float* ssq; float qscale; const float* rope;
    __device__ __forceinline__ void operator()(const f32x4 (&acc)[2][2][4][2], const Unit& u, int wr, int wc, int fr, int fq) const {
        const int row0 = u.pm * BM + wr * 64 + fr, col0 = u.pn * BM + wc * 32 + 8 * fq;
#pragma unroll
        for (int ai = 0; ai < 2; ++ai)
#pragma unroll
            for (int m = 0; m < 4; ++m) { const int row = row0 + ai * HALF + m * 16; const float rs = row_rstd4(ssq, row, fq, 1.0f / 256.0f) * qscale;
                bf16_t* rowp = Qd + (size_t)row * 768 + col0; const int pos = row & 2047; const float* rp = rope + ((size_t)pos * 16 + 8 * (fq & 1)) * 2;
#pragma unroll
                for (int bj = 0; bj < 2; ++bj) { f32x4 v0 = acc[ai][bj][m][0] * rs, v1 = acc[ai][bj][m][1] * rs;
                    const int g = u.pn * 8 + bj * 4 + wc;
                    if (g % 3 == 2) { f32x4 o0, o1;
#pragma unroll
                        for (int e = 0; e < 8; ++e) { const float v = e < 4 ? v0[e] : v1[e - 4]; const float w = __shfl_xor(v, 32); const float c = rp[2 * e], sn = rp[2 * e + 1];
                            const float o = (fq < 2) ? (v * c - w * sn) : (w * sn + v * c); if (e < 4) o0[e] = o; else o1[e - 4] = o; }
                        v0 = o0; v1 = o1; }
                    *(u32x4*)(rowp + bj * HALF) = pack8(v0, v1); } }
    }
};
struct EpiUkv {
    static constexpr bool PERM = true, AFTER_DRAIN = false;
    bf16_t* Kd; bf16_t* Vd; const float* sskv;
    __device__ __forceinline__ void operator()(const f32x4 (&acc)[2][2][4][2], const Unit& u, int wr, int wc, int fr, int fq) const {
        const int row0 = u.pm * BM + wr * 64 + fr;
#pragma unroll
        for (int ai = 0; ai < 2; ++ai)
#pragma unroll
            for (int m = 0; m < 4; ++m) { const int row = row0 + ai * HALF + m * 16; const float rs = row_rstd4(sskv, row, fq, 1.0f / 128.0f);
#pragma unroll
                for (int bj = 0; bj < 2; ++bj) { const f32x4 v0 = acc[ai][bj][m][0] * rs, v1 = acc[ai][bj][m][1] * rs; const int h = u.pn * 2 + bj, j = wc * 32 + 8 * fq;
                    bf16_t* dst = (wc < 2) ? (Kd + (size_t)row * 768 + h * 96 + j) : (Vd + (size_t)row * 512 + h * 64 + (j - 64));
                    *(u32x4*)dst = pack8(v0, v1); } }
    }
};

template <class Epi, class Sched, bool ALIGN_EPI = false, bool SP2 = false>
__device__ __forceinline__ void gemm_phase(PG8_LAS unsigned char* lds, const Gemm g, const Sched& S, const Epi& E) {
    const int tid = threadIdx.x, wid = __builtin_amdgcn_readfirstlane(tid >> 6), lane = tid & 63, wr = wid >> 2, wc = wid & 3, fr = lane & 15, fq = lane >> 4;
    const int K = g.K, nt = K / BK;
    unsigned voffA[2], voffB[2];
#pragma unroll
    for (int i = 0; i < 2; ++i) { int R, C; stage_rc(tid * 16 + i * 8192, R, C); const int Rb = Epi::PERM ? ((R & ~31) + perm32(R & 31)) : R;
        voffA[i] = (unsigned)(R * g.lda + C) * 2u; voffB[i] = (unsigned)(Rb * K + C) * 2u; }
    const size_t kstep = (size_t)(BK * 2);
    const size_t hstep = (size_t)HALF * K * 2;
    const size_t tstep = 2 * hstep; const size_t hstepA = (size_t)HALF * g.lda * 2, tstepA = 2 * hstepA;
    const unsigned ldsw = (unsigned)wid * 1024u;
    const int aoff = lds_byte(wr * 64 + fr, fq * 8), boff = lds_byte(wc * 32 + fr, fq * 8);
#define PG8_SA(b, h) (((b) * 2 + (h)) * HTB)
#define PG8_SB(b, h) ((4 + (b) * 2 + (h)) * HTB)
#define PG8_STAGE(bufoff, gbase, voff) do { _Pragma("unroll") for (int _i = 0; _i < 2; ++_i) \
        __builtin_amdgcn_global_load_lds((const unsigned*)((const char*)(gbase) + (voff)[_i]), (PG8_LAS unsigned*)(lds + (bufoff) + ldsw + _i * 8192), 16, 0, 0); } while (0)
#define PG8_LDA(dst, b, h) do { _Pragma("unroll") for (int m = 0; m < 4; ++m) _Pragma("unroll") for (int k = 0; k < 2; ++k) dst[m][k] = *(const PG8_LAS bf16x8*)(lds + PG8_SA(b, h) + aoff + m * 2048 + k * 1024); } while (0)
#define PG8_LDB(dst, b, h) do { _Pragma("unroll") for (int n = 0; n < 2; ++n) _Pragma("unroll") for (int k = 0; k < 2; ++k) dst[n][k] = *(const PG8_LAS bf16x8*)(lds + PG8_SB(b, h) + boff + n * 2048 + k * 1024); } while (0)
#define PG8_MMA(ai, bj, At, Bt) do { __builtin_amdgcn_s_setprio(1); _Pragma("unroll") for (int m = 0; m < 4; ++m) _Pragma("unroll") for (int n = 0; n < 2; ++n) _Pragma("unroll") for (int k = 0; k < 2; ++k) \
        acc[ai][bj][m][n] = __builtin_amdgcn_mfma_f32_16x16x32_bf16(Bt[n][k], At[m][k], acc[ai][bj][m][n], 0, 0, 0); __builtin_amdgcn_s_setprio(0); } while (0)
#define PG8_WAIT_V(n) asm volatile("s_waitcnt vmcnt(" #n ")" ::: "memory")
#define PG8_WAIT_L(n) asm volatile("s_waitcnt lgkmcnt(" #n ")" ::: "memory")
#define PG8_BAR __builtin_amdgcn_s_barrier()
#define PG8_SCHED __builtin_amdgcn_sched_barrier(0)
    Unit cur, nxt; int ui = 0;
    if (!S.next(0, cur)) return;
    f32x4 acc[2][2][4][2];
#pragma unroll
    for (int a = 0; a < 2; ++a)
#pragma unroll
        for (int b = 0; b < 2; ++b)
#pragma unroll
            for (int m = 0; m < 4; ++m)
#pragma unroll
                for (int n = 0; n < 2; ++n) acc[a][b][m][n] = (f32x4){0.f, 0.f, 0.f, 0.f};
    bf16x8 At[4][2], B0[2][2], B1[2][2];
    const char* cA = (const char*)g.A + (size_t)cur.pm * tstepA; const char* cB = (const char*)g.Bt + (size_t)cur.pn * tstep;
    S.a_ready(cur);
    if constexpr (SP2) {
        PG8_STAGE(PG8_SB(0, 0), cB, voffB); PG8_STAGE(PG8_SB(0, 1), cB + hstep, voffB); PG8_STAGE(PG8_SA(0, 0), cA, voffA); PG8_STAGE(PG8_SA(0, 1), cA + hstepA, voffA);
        if (wr == 1) PG8_BAR;
        PG8_WAIT_V(2); PG8_BAR;
        PG8_STAGE(PG8_SB(1, 0), cB + kstep, voffB); PG8_STAGE(PG8_SA(1, 0), cA + kstep, voffA); PG8_STAGE(PG8_SB(1, 1), cB + hstep + kstep, voffB);
        PG8_WAIT_V(6); PG8_BAR;
    } else {
        PG8_STAGE(PG8_SB(0, 0), cB, voffB); PG8_STAGE(PG8_SA(0, 0), cA, voffA); PG8_STAGE(PG8_SB(0, 1), cB + hstep, voffB); PG8_STAGE(PG8_SA(0, 1), cA + hstepA, voffA);
        if (wr == 1) PG8_BAR;
        PG8_WAIT_V(4); PG8_BAR;
        PG8_STAGE(PG8_SB(1, 0), cB + kstep, voffB); PG8_STAGE(PG8_SA(1, 0), cA + kstep, voffA); PG8_STAGE(PG8_SB(1, 1), cB + hstep + kstep, voffB);
        PG8_WAIT_V(6); PG8_BAR;
    }
    for (;;) {
        const bool has_next = S.next(ui + 1, nxt);
        const char* nA = has_next ? (const char*)g.A + (size_t)nxt.pm * tstepA : cA; const char* nB = has_next ? (const char*)g.Bt + (size_t)nxt.pn * tstep : cB;
        for (int t = 0; t < nt; t += 2) {
            const bool last = (t == nt - 2);
            const char* a1 = cA + (size_t)(t + 1) * kstep;
            const char* a2 = last ? nA : cA + (size_t)(t + 2) * kstep; const char* b2 = last ? nB : cB + (size_t)(t + 2) * kstep;
            const char* a3 = a2 + kstep; const char* b3 = b2 + kstep;
            if (last && has_next) S.a_ready(nxt);
            if constexpr (SP2) {
            PG8_LDB(B0, 0, 0); PG8_LDB(B1, 0, 1); PG8_SCHED; PG8_LDA(At, 0, 0); PG8_STAGE(PG8_SA(1, 1), a1 + hstepA, voffA);
            PG8_WAIT_V(8); PG8_WAIT_L(0); PG8_BAR; PG8_MMA(0, 0, At, B0); PG8_MMA(0, 1, At, B1); PG8_BAR; PG8_SCHED;
            PG8_LDA(At, 0, 1); PG8_STAGE(PG8_SB(0, 0), b2, voffB); PG8_STAGE(PG8_SB(0, 1), b2 + hstep, voffB); PG8_STAGE(PG8_SA(0, 0), a2, voffA);
            PG8_WAIT_V(8); PG8_WAIT_L(0); PG8_BAR; PG8_MMA(1, 0, At, B0); PG8_MMA(1, 1, At, B1); PG8_BAR; PG8_SCHED;
            PG8_LDB(B0, 1, 0); PG8_LDB(B1, 1, 1); PG8_SCHED; PG8_LDA(At, 1, 0); PG8_STAGE(PG8_SA(0, 1), a2 + hstepA, voffA);
            PG8_WAIT_V(8); PG8_WAIT_L(0); PG8_BAR; PG8_MMA(0, 0, At, B0); PG8_MMA(0, 1, At, B1); PG8_BAR; PG8_SCHED;
            PG8_LDA(At, 1, 1); PG8_STAGE(PG8_SB(1, 0), b3, voffB); PG8_STAGE(PG8_SB(1, 1), b3 + hstep, voffB); PG8_STAGE(PG8_SA(1, 0), a3, voffA);
            PG8_WAIT_V(8); PG8_WAIT_L(0); PG8_BAR; PG8_MMA(1, 0, At, B0); PG8_MMA(1, 1, At, B1); PG8_BAR; PG8_SCHED;
            } else {
            PG8_LDB(B0, 0, 0); PG8_SCHED; PG8_LDA(At, 0, 0); PG8_STAGE(PG8_SA(1, 1), a1 + hstepA, voffA);
            PG8_WAIT_L(8); PG8_BAR; PG8_WAIT_L(0); PG8_MMA(0, 0, At, B0); PG8_BAR; PG8_SCHED;
            PG8_LDB(B1, 0, 1); PG8_STAGE(PG8_SB(0, 0), b2, voffB);
            PG8_BAR; PG8_WAIT_L(0); PG8_MMA(0, 1, At, B1); PG8_BAR;
            PG8_LDA(At, 0, 1); PG8_STAGE(PG8_SA(0, 0), a2, voffA);
            PG8_BAR; PG8_WAIT_L(0); PG8_MMA(1, 0, At, B0); PG8_BAR; PG8_SCHED;
            PG8_STAGE(PG8_SB(0, 1), b2 + hstep, voffB);
            PG8_WAIT_V(6); PG8_BAR; PG8_MMA(1, 1, At, B1); PG8_BAR;
            PG8_LDB(B0, 1, 0); PG8_SCHED; PG8_LDA(At, 1, 0); PG8_STAGE(PG8_SA(0, 1), a2 + hstepA, voffA);
            PG8_WAIT_L(8); PG8_BAR; PG8_WAIT_L(0); PG8_MMA(0, 0, At, B0); PG8_BAR; PG8_SCHED;
            PG8_LDB(B1, 1, 1); PG8_STAGE(PG8_SB(1, 0), b3, voffB);
            PG8_BAR; PG8_WAIT_L(0); PG8_MMA(0, 1, At, B1); PG8_BAR;
            PG8_LDA(At, 1, 1); PG8_STAGE(PG8_SA(1, 0), a3, voffA);
            PG8_BAR; PG8_WAIT_L(0); PG8_MMA(1, 0, At, B0); PG8_BAR; PG8_SCHED;
            PG8_STAGE(PG8_SB(1, 1), b3 + hstep, voffB);
            PG8_WAIT_V(6); PG8_BAR; PG8_MMA(1, 1, At, B1); PG8_BAR;
            }
        }
        if constexpr (ALIGN_EPI) { if (wr == 0) PG8_BAR; }
        if constexpr (!Epi::AFTER_DRAIN) { E(acc, cur, wr, wc, fr, fq); S.done(cur); }
        if (!has_next) break;
#pragma unroll
        for (int a = 0; a < 2; ++a)
#pragma unroll
            for (int b = 0; b < 2; ++b)
#pragma unroll
                for (int m = 0; m < 4; ++m)
#pragma unroll
                    for (int n = 0; n < 2; ++n) acc[a][b][m][n] = (f32x4){0.f, 0.f, 0.f, 0.f};
        cur = nxt; cA = nA; cB = nB; ++ui;
        if constexpr (ALIGN_EPI) { if (wr == 1) PG8_BAR; }
    }
    PG8_WAIT_V(0);
    if constexpr (!ALIGN_EPI) { if (wr == 0) PG8_BAR; }
    PG8_BAR;
    if constexpr (Epi::AFTER_DRAIN) { E.fused(acc, cur, wr, wc, fr, fq, lds, wid, lane); S.done(cur); }
#undef PG8_SA
#undef PG8_SB
#undef PG8_STAGE
#undef PG8_LDA
#undef PG8_LDB
#undef PG8_MMA
#undef PG8_WAIT_V
#undef PG8_WAIT_L
#undef PG8_BAR
#undef PG8_SCHED
}
}

namespace att {
#define ALAS __attribute__((address_space(3)))
typedef unsigned short bf16_t;
typedef short bf16x8 __attribute__((ext_vector_type(8)));
typedef short s16x4 __attribute__((ext_vector_type(4)));
typedef float f32x4 __attribute__((ext_vector_type(4)));
typedef float f32x16 __attribute__((ext_vector_type(16)));
typedef unsigned u32x4 __attribute__((ext_vector_type(4)));
typedef unsigned u32x2 __attribute__((ext_vector_type(2)));
typedef float f32x2_t __attribute__((ext_vector_type(2))); typedef __bf16 bf16x2_t __attribute__((ext_vector_type(2)));
constexpr float LOG2E = 1.4426950408889634f;
constexpr int BIAS_LDS_OFF = 65536;
__device__ __forceinline__ unsigned cvtpk(float lo, float hi) { f32x2_t v = {lo, hi}; bf16x2_t b = __builtin_convertvector(v, bf16x2_t); return __builtin_bit_cast(unsigned, b); }
__device__ __forceinline__ s16x4 vtr(const ALAS unsigned char* p) { typedef short v4i16_t __attribute__((ext_vector_type(4))); return __builtin_bit_cast(s16x4, __builtin_amdgcn_ds_read_tr16_b64_v4i16((ALAS v4i16_t*)p)); }
__device__ __forceinline__ int crow(int i, int hi) { return (i & 3) + 8 * (i >> 2) + 4 * hi; }

struct AU {
    const bf16_t* Q; int ldq;
    const bf16_t* K; int ldk;
    const bf16_t* V; int ldv;
    bf16_t* O; int ldo;
    int tok0;
    int qpos;
    int t_lo, t_hi;
    const float* F2; float cb;
    const ALAS float* bias;
    float sink2;
    const unsigned long long* bm;
};

constexpr float THR = 8.0f;
__device__ __forceinline__ float hmax(float v) { auto rr = __builtin_amdgcn_permlane32_swap(__float_as_uint(v), __float_as_uint(v), false, false); return fmaxf(__uint_as_float(rr[0]), __uint_as_float(rr[1])); }
__device__ __forceinline__ float hsum(float v) { auto rr = __builtin_amdgcn_permlane32_swap(__float_as_uint(v), __float_as_uint(v), false, false); return __uint_as_float(rr[0]) + __uint_as_float(rr[1]); }
struct SMState { float m, l; f32x16 o0, o1, negm; bool first; };
template <int DK, int MODE>
__device__ __forceinline__ void tile_compute(const AU& u, const ALAS unsigned char* Kb, int t, SMState& st, const bf16x8 (&qr)[DK / 16], unsigned koff, unsigned vbase, int q, int hi) {
    constexpr int KSTR = DK * 2 + 16, KB = 64 * KSTR, VB = 8192, NKS = DK / 16;
    const int kt0 = t * 64;
    unsigned long long mw = 0ull;
    if (MODE == 2) mw = u.bm[(size_t)q * 32 + t];
    bf16x8 kf[2 * NKS];
#pragma unroll
    for (int ks = 0; ks < NKS; ++ks) { kf[2 * ks] = *(const ALAS bf16x8*)(Kb + koff + ks * 32); kf[2 * ks + 1] = *(const ALAS bf16x8*)(Kb + koff + 32 * KSTR + ks * 32); }
    f32x16 p0, p1;
    if (MODE == 0) { const ALAS float* fk = (const ALAS float*)(Kb + KB + VB);
#pragma unroll
        for (int g = 0; g < 4; ++g) { const f32x4 a = *(const ALAS f32x4*)(fk + 8 * g + 4 * hi), b = *(const ALAS f32x4*)(fk + 32 + 8 * g + 4 * hi);
#pragma unroll
            for (int e = 0; e < 4; ++e) { p0[4 * g + e] = a[e] - st.m; p1[4 * g + e] = b[e] - st.m; } } }
    else { p0 = st.negm; p1 = st.negm; }
    __builtin_amdgcn_sched_barrier(0);
#pragma unroll
    for (int ks = 0; ks < NKS; ++ks) {
        p0 = __builtin_amdgcn_mfma_f32_32x32x16_bf16(kf[2 * ks], qr[ks], p0, 0, 0, 0);
        p1 = __builtin_amdgcn_mfma_f32_32x32x16_bf16(kf[2 * ks + 1], qr[ks], p1, 0, 0, 0);
    }
    const ALAS unsigned char* vp = Kb + vbase;
    s16x4 va[4][4];
#pragma unroll
    for (int s = 0; s < 4; ++s) { va[s][0] = vtr(vp + s * 2048); va[s][1] = vtr(vp + s * 2048 + 1024); va[s][2] = vtr(vp + s * 2048 + 256); va[s][3] = vtr(vp + s * 2048 + 1024 + 256); }
    __builtin_amdgcn_sched_barrier(0);
    if (MODE == 0 || MODE == 3) {
        if (kt0 + 63 > u.qpos) {
#pragma unroll
            for (int i = 0; i < 16; ++i) { const int key = kt0 + crow(i, hi); if (key > q) p0[i] = -INFINITY; if (key + 32 > q) p1[i] = -INFINITY; } }
    } else if (MODE == 1 || kt0 + 63 + 127 >= u.qpos) {
        const int db = q - kt0 - 4 * hi;
#pragma unroll
        for (int i = 0; i < 16; ++i) { const int d0 = db - ((i & 3) + 8 * (i >> 2)), d1 = d0 - 32;
            const int i0 = d0 < 0 ? 0 : (d0 > 127 ? 127 : d0), i1 = d1 < 0 ? 0 : (d1 > 127 ? 127 : d1);
            p0[i] += u.bias[i0]; p1[i] += u.bias[i1]; }
    }
    float rm = fmaxf(fmaxf(p0[0], p0[1]), p1[0]), rb = fmaxf(fmaxf(p0[2], p0[3]), p1[1]); rm = fmaxf(fmaxf(rm, p1[2]), p1[3]);
#pragma unroll
    for (int i = 4; i < 16; i += 4) { rm = fmaxf(fmaxf(rm, p0[i]), p0[i + 1]); rb = fmaxf(fmaxf(rb, p0[i + 2]), p0[i + 3]); rm = fmaxf(fmaxf(rm, p1[i]), p1[i + 1]); rb = fmaxf(fmaxf(rb, p1[i + 2]), p1[i + 3]); }
    rm = hmax(fmaxf(rm, rb));
    if (st.first || __any(rm > THR)) {
        const float dl = st.first ? rm : (rm > THR ? rm : 0.f); st.m += dl;
#pragma unroll
        for (int i = 0; i < 16; ++i) { p0[i] -= dl; p1[i] -= dl; st.negm[i] = -st.m; }
        if (!st.first) { const float f = __builtin_amdgcn_exp2f(-dl); st.l *= f;
#pragma unroll
            for (int i = 0; i < 16; ++i) { st.o0[i] *= f; st.o1[i] *= f; } }
        st.first = false;
    }
#pragma unroll
    for (int i = 0; i < 16; ++i) { p0[i] = __builtin_amdgcn_exp2f(p0[i]); p1[i] = __builtin_amdgcn_exp2f(p1[i]); }
    if (MODE == 1) { const int db = q - kt0 - 4 * hi;
#pragma unroll
        for (int i = 0; i < 16; ++i) { const int d0 = db - ((i & 3) + 8 * (i >> 2)), d1 = d0 - 32; p0[i] = ((unsigned)d0 < 128u) ? p0[i] : 0.f; p1[i] = ((unsigned)d1 < 128u) ? p1[i] : 0.f; } }
    if (MODE == 2) { const int lo = (int)((unsigned)mw >> (4 * hi)), hw = (int)((unsigned)(mw >> 32) >> (4 * hi));
#pragma unroll
        for (int i = 0; i < 16; ++i) { const int bit = (i & 3) + 8 * (i >> 2);
            p0[i] = __uint_as_float(__float_as_uint(p0[i]) & (unsigned)__builtin_amdgcn_sbfe(lo, bit, 1)); p1[i] = __uint_as_float(__float_as_uint(p1[i]) & (unsigned)__builtin_amdgcn_sbfe(hw, bit, 1)); } }
    float rs0 = 0.f, rs1 = 0.f;
#pragma unroll
    for (int i = 0; i < 16; ++i) { rs0 += p0[i]; rs1 += p1[i]; }
    st.l += rs0 + rs1;
    u32x4 pw[4];
#pragma unroll
    for (int s = 0; s < 2; ++s) { pw[s] = (u32x4){cvtpk(p0[8 * s], p0[8 * s + 1]), cvtpk(p0[8 * s + 2], p0[8 * s + 3]), cvtpk(p0[8 * s + 4], p0[8 * s + 5]), cvtpk(p0[8 * s + 6], p0[8 * s + 7])};
        pw[2 + s] = (u32x4){cvtpk(p1[8 * s], p1[8 * s + 1]), cvtpk(p1[8 * s + 2], p1[8 * s + 3]), cvtpk(p1[8 * s + 4], p1[8 * s + 5]), cvtpk(p1[8 * s + 6], p1[8 * s + 7])}; }
#pragma unroll
    for (int s = 0; s < 4; ++s) {
        const bf16x8 vf0 = (bf16x8){va[s][0][0], va[s][0][1], va[s][0][2], va[s][0][3], va[s][1][0], va[s][1][1], va[s][1][2], va[s][1][3]};
        const bf16x8 vf1 = (bf16x8){va[s][2][0], va[s][2][1], va[s][2][2], va[s][2][3], va[s][3][0], va[s][3][1], va[s][3][2], va[s][3][3]};
        const bf16x8 pf = __builtin_bit_cast(bf16x8, pw[s]);
        st.o0 = __builtin_amdgcn_mfma_f32_32x32x16_bf16(vf0, pf, st.o0, 0, 0, 0);
        st.o1 = __builtin_amdgcn_mfma_f32_32x32x16_bf16(vf1, pf, st.o1, 0, 0, 0);
    }
}
template <int DK, int MODE>
__device__ __forceinline__ void attn_unit(const AU& u, ALAS unsigned char* lds) {
    constexpr int KSTR = DK * 2 + 16, KB = 64 * KSTR, VB = 8192, BUF = KB + VB + 256, NKS = DK / 16, CPR = DK / 8;
    static_assert(3 * BUF <= BIAS_LDS_OFF, "attention ring vs bias tables");
    const int tid = threadIdx.x, lane = tid & 63, r32 = lane & 31, hi = lane >> 5;
    const int q = u.qpos + r32;
    bf16x8 qr[NKS];
    { const bf16_t* qp = u.Q + (size_t)(u.tok0 + q) * u.ldq + hi * 8;
#pragma unroll
      for (int ks = 0; ks < NKS; ++ks) qr[ks] = *(const bf16x8*)(qp + ks * 16); }
    const int kr0 = tid / CPR, kc0 = tid % CPR, kr1 = (tid + 512) / CPR, kc1 = (tid + 512) % CPR;
    const int vr = tid >> 3, vc = tid & 7;
    const unsigned kdst0 = kr0 * KSTR + kc0 * 16, kdst1 = kr1 * KSTR + kc1 * 16;
    const unsigned vdst = KB + ((vr >> 2) * 2 + (vc >> 2)) * 256 + (vr & 3) * 64 + (vc & 3) * 16;
    const bf16_t* kg0 = u.K + (size_t)(u.tok0 + kr0) * u.ldk + kc0 * 8;
    const bf16_t* kg1 = u.K + (size_t)(u.tok0 + kr1) * u.ldk + kc1 * 8;
    const bf16_t* vg = u.V + (size_t)(u.tok0 + vr) * u.ldv + vc * 8;
    const bool k2 = (DK == 96) && (tid < 256);
    u32x4 kA0, kA1 = {0u, 0u, 0u, 0u}, vA, kB0, kB1 = {0u, 0u, 0u, 0u}, vB; float fA = 0.f, fB = 0.f;
#define AT_LOAD(S, t) do { const size_t ro_ = (size_t)(t) * 64; k##S##0 = *(const u32x4*)(kg0 + ro_ * u.ldk); if (k2) k##S##1 = *(const u32x4*)(kg1 + ro_ * u.ldk); \
        v##S = *(const u32x4*)(vg + ro_ * u.ldv); if (MODE == 0) { if (tid < 64) f##S = u.cb - u.F2[(t) * 64 + tid]; } } while (0)
#define AT_STORE(S, bo) do { ALAS unsigned char* b_ = lds + (bo); *(ALAS u32x4*)(b_ + kdst0) = k##S##0; if (k2) *(ALAS u32x4*)(b_ + kdst1) = k##S##1; \
        *(ALAS u32x4*)(b_ + vdst) = v##S; if (MODE == 0) { if (tid < 64) *(ALAS float*)(b_ + KB + VB + tid * 4) = f##S; } } while (0)
    SMState st; st.m = 0.f; st.l = 0.f; st.o0 = f32x16{}; st.o1 = f32x16{}; st.negm = f32x16{}; st.first = true;
    const unsigned koff = r32 * KSTR + hi * 16;
    const unsigned vbase = KB + hi * 512 + ((lane & 15) >> 2) * 64 + ((lane >> 4) & 1) * 32 + (lane & 3) * 8;
    const int n = u.t_hi - u.t_lo;
    AT_LOAD(A, u.t_lo); AT_STORE(A, 0); if (n > 1) AT_LOAD(B, u.t_lo + 1);
    __syncthreads();
    int bo = 0;
#define AT_BAR() do { asm volatile("s_waitcnt lgkmcnt(0)" ::: "memory"); __builtin_amdgcn_s_barrier(); asm volatile("" ::: "memory"); } while (0)
#define AT_ACTIVE(t) (((t) * 64 <= u.qpos + 31) && (MODE != 1 || (t) * 64 + 63 + 127 >= u.qpos))
    for (int i = 0; i < n; i += 2) {
        { const int t = u.t_lo + i; const int bn = (bo == 2 * BUF) ? 0 : bo + BUF;
          if (i + 2 < n) AT_LOAD(A, t + 2);
          if (AT_ACTIVE(t)) tile_compute<DK, MODE>(u, lds + bo, t, st, qr, koff, vbase, q, hi);
          if (i + 1 < n) AT_STORE(B, bn);
          AT_BAR(); bo = bn; }
        if (i + 1 < n) { const int t = u.t_lo + i + 1; const int bn = (bo == 2 * BUF) ? 0 : bo + BUF;
          if (i + 3 < n) AT_LOAD(B, t + 2);
          if (AT_ACTIVE(t)) tile_compute<DK, MODE>(u, lds + bo, t, st, qr, koff, vbase, q, hi);
          if (i + 2 < n) AT_STORE(A, bn);
          AT_BAR(); bo = bn; }
    }
#undef AT_LOAD
#undef AT_STORE
#undef AT_ACTIVE
#undef AT_BAR
    float l = hsum(st.l);
    if (MODE == 1) l += __builtin_amdgcn_exp2f(u.sink2 - st.m);
    const float inv = 1.0f / l;
    bf16_t* op = u.O + (size_t)(u.tok0 + q) * u.ldo + 4 * hi;
#pragma unroll
    for (int g = 0; g < 4; ++g) {
        u32x2 w0 = {cvtpk(st.o0[4 * g] * inv, st.o0[4 * g + 1] * inv), cvtpk(st.o0[4 * g + 2] * inv, st.o0[4 * g + 3] * inv)};
        u32x2 w1 = {cvtpk(st.o1[4 * g] * inv, st.o1[4 * g + 1] * inv), cvtpk(st.o1[4 * g + 2] * inv, st.o1[4 * g + 3] * inv)};
        *(u32x2*)(op + 8 * g) = w0; *(u32x2*)(op + 32 + 8 * g) = w1;
    }
}

constexpr int SROW = 2052;
__device__ __forceinline__ unsigned wave_sum_u32(unsigned v) {
    v += (unsigned)__builtin_amdgcn_update_dpp(0, (int)v, 0xB1, 0xF, 0xF, true);
    v += (unsigned)__builtin_amdgcn_update_dpp(0, (int)v, 0x4E, 0xF, 0xF, true);
    v += (unsigned)__builtin_amdgcn_update_dpp(0, (int)v, 0x141, 0xF, 0xF, true);
    v += (unsigned)__builtin_amdgcn_update_dpp(0, (int)v, 0x140, 0xF, 0xF, true);
    return (unsigned)__builtin_amdgcn_readlane((int)v, 0) + (unsigned)__builtin_amdgcn_readlane((int)v, 16) + (unsigned)__builtin_amdgcn_readlane((int)v, 32) + (unsigned)__builtin_amdgcn_readlane((int)v, 48);
}
__device__ __forceinline__ unsigned wave_min_u32(unsigned v) {
    v = min(v, (unsigned)__builtin_amdgcn_update_dpp(-1, (int)v, 0xB1, 0xF, 0xF, false));
    v = min(v, (unsigned)__builtin_amdgcn_update_dpp(-1, (int)v, 0x4E, 0xF, 0xF, false));
    v = min(v, (unsigned)__builtin_amdgcn_update_dpp(-1, (int)v, 0x141, 0xF, 0xF, false));
    v = min(v, (unsigned)__builtin_amdgcn_update_dpp(-1, (int)v, 0x140, 0xF, 0xF, false));
    return min(min((unsigned)__builtin_amdgcn_readlane((int)v, 0), (unsigned)__builtin_amdgcn_readlane((int)v, 16)), min((unsigned)__builtin_amdgcn_readlane((int)v, 32), (unsigned)__builtin_amdgcn_readlane((int)v, 48)));
}
__device__ __forceinline__ unsigned wave_max_u32(unsigned v) {
    v = max(v, (unsigned)__builtin_amdgcn_update_dpp(0, (int)v, 0xB1, 0xF, 0xF, false));
    v = max(v, (unsigned)__builtin_amdgcn_update_dpp(0, (int)v, 0x4E, 0xF, 0xF, false));
    v = max(v, (unsigned)__builtin_amdgcn_update_dpp(0, (int)v, 0x141, 0xF, 0xF, false));
    v = max(v, (unsigned)__builtin_amdgcn_update_dpp(0, (int)v, 0x140, 0xF, 0xF, false));
    return max(max((unsigned)__builtin_amdgcn_readlane((int)v, 0), (unsigned)__builtin_amdgcn_readlane((int)v, 16)), max((unsigned)__builtin_amdgcn_readlane((int)v, 32), (unsigned)__builtin_amdgcn_readlane((int)v, 48)));
}
__device__ __forceinline__ float unsortable(unsigned k) { return __uint_as_float((k & 0x80000000u) ? (k & 0x7FFFFFFFu) : ~k); }
template <int LN> __device__ __forceinline__ void wlane(unsigned& dst, unsigned val) { asm volatile("s_nop 1\n\tv_writelane_b32 %0, %1, %2" : "+v"(dst) : "s"(val), "i"(LN)); }
template <int I, int NREG> __device__ __forceinline__ void fin_fast(const unsigned (&ua)[NREG], const unsigned (&ub)[NREG], unsigned Ta, unsigned Tb, unsigned& alo, unsigned& ahi, unsigned& blo, unsigned& bhi) {
    if constexpr (I < NREG) { const unsigned long long wa = __ballot(ua[I] >= Ta), wb = __ballot(ub[I] >= Tb);
        wlane<I>(alo, (unsigned)wa); wlane<I>(ahi, (unsigned)(wa >> 32)); wlane<I>(blo, (unsigned)wb); wlane<I>(bhi, (unsigned)(wb >> 32));
        fin_fast<I + 1, NREG>(ua, ub, Ta, Tb, alo, ahi, blo, bhi); }
}
__device__ __forceinline__ unsigned sortable(float f) { const unsigned b = __float_as_uint(f); return (b & 0x80000000u) ? ~b : (b | 0x80000000u); }
__device__ __forceinline__ unsigned bracket_mid(unsigned lo, unsigned hi, bool integer_only) {
    const unsigned im = lo + ((hi - lo) >> 1);
    if (integer_only) return im;
    const float m = 0.5f * unsortable(lo) + 0.5f * unsortable(hi); const unsigned mk = sortable(m);
    return (mk > lo && mk < hi) ? mk : im;
}
template <int NREG>
__device__ __forceinline__ void select2(const ALAS float* Sa, const ALAS float* Sb, int ta, unsigned long long* bma, unsigned long long* bmb, int lane, int itcap, int nreg, const ALAS unsigned* mm) {
    unsigned ua[NREG], ub[NREG];
#pragma unroll
    for (int i = 0; i < NREG; ++i) { ua[i] = 0u; ub[i] = 0u; if (i < nreg) { const unsigned xa_ = sortable(Sa[64 * i + lane]), xb_ = sortable(Sb[64 * i + lane]); ua[i] = (64 * i + lane <= ta) ? xa_ : 0u; ub[i] = (64 * i + lane <= ta + 1) ? xb_ : 0u; } }
    unsigned Ta = (unsigned)__builtin_amdgcn_readfirstlane((int)mm[0]) + 1u, Tb = (unsigned)__builtin_amdgcn_readfirstlane((int)mm[1]) + 1u, Ha = (unsigned)__builtin_amdgcn_readfirstlane((int)mm[16]) + 1u, Hb = (unsigned)__builtin_amdgcn_readfirstlane((int)mm[17]) + 1u;
    unsigned ca = (unsigned)(ta + 1), cb = (unsigned)(ta + 2); bool da = false, db = false;
#pragma unroll 1
    for (int it = 0; it < itcap; ++it) {
        const unsigned xa = da ? Ta : bracket_mid(Ta, Ha, it >= 28), xb = db ? Tb : bracket_mid(Tb, Hb, it >= 28);
        unsigned na = 0u, nb = 0u;
#pragma unroll
        for (int i = 0; i < NREG; ++i) { na += (unsigned)__builtin_popcountll(__ballot(ua[i] >= xa)); nb += (unsigned)__builtin_popcountll(__ballot(ub[i] >= xb)); }
        if (!da) { if (na >= 256u) { Ta = xa; ca = na; } else Ha = xa; da = (ca == 256u) || (Ha - Ta <= 1u); }
        if (!db) { if (nb >= 256u) { Tb = xb; cb = nb; } else Hb = xb; db = (cb == 256u) || (Hb - Tb <= 1u); }
        if (da && db) break;
    }
    unsigned long long mya = 0ull, myb = 0ull; unsigned mya_lo = 0u, mya_hi = 0u, myb_lo = 0u, myb_hi = 0u;
    if (ca == 256u && cb == 256u) {
        fin_fast<0, NREG>(ua, ub, Ta, Tb, mya_lo, mya_hi, myb_lo, myb_hi);
        mya = ((unsigned long long)mya_hi << 32) | mya_lo; myb = ((unsigned long long)myb_hi << 32) | myb_lo;
    } else {
        unsigned g = 0u;
#pragma unroll
        for (int i = 0; i < NREG; ++i) { g += (ua[i] > Ta) ? 1u : 0u; g += (ub[i] > Tb) ? 0x10000u : 0u; }
        const unsigned gt = wave_sum_u32(g); int needa = 256 - (int)(gt & 0xFFFFu), needb = 256 - (int)(gt >> 16);
#pragma unroll
        for (int i = 0; i < NREG; ++i) {
            const unsigned long long ga = __ballot(ua[i] > Ta), ea = __ballot(ua[i] == Ta), gb = __ballot(ub[i] > Tb), eb = __ballot(ub[i] == Tb);
            const int rka = __builtin_amdgcn_mbcnt_hi((unsigned)(ea >> 32), __builtin_amdgcn_mbcnt_lo((unsigned)ea, 0u)), rkb = __builtin_amdgcn_mbcnt_hi((unsigned)(eb >> 32), __builtin_amdgcn_mbcnt_lo((unsigned)eb, 0u));
            const unsigned long long tka = __ballot((ua[i] == Ta) && (rka < needa)), tkb = __ballot((ub[i] == Tb) && (rkb < needb));
            needa -= __builtin_popcountll(tka); needb -= __builtin_popcountll(tkb);
            if (lane == i) { mya = ga | tka; myb = gb | tkb; } }
    }
    if (lane < 32) { bma[lane] = mya; bmb[lane] = myb; }
}
__device__ __forceinline__ float wave_minf(float v) {
#pragma unroll
    for (int o = 1; o < 64; o <<= 1) v = fminf(v, __shfl_xor(v, o));
    return v;
}
__device__ __forceinline__ float wave_maxf(float v) {
#pragma unroll
    for (int o = 1; o < 64; o <<= 1) v = fmaxf(v, __shfl_xor(v, o));
    return v;
}
template <int NREG>
__device__ __forceinline__ void hist_level(const unsigned (&breg)[NREG], ALAS unsigned* hist, int lane, unsigned& need, unsigned& bstar, unsigned& ncand) {
    *(ALAS u32x4*)(hist + 4 * lane) = (u32x4){0u, 0u, 0u, 0u};
#pragma unroll
    for (int i = 0; i < NREG; ++i) { if (breg[i] - 1u < 256u) __hip_atomic_fetch_add(hist + breg[i] - 1u, 1u, __ATOMIC_RELAXED, __HIP_MEMORY_SCOPE_WORKGROUP); }
    const u32x4 h4 = *(const ALAS u32x4*)(hist + 252 - 4 * lane);
    const unsigned loc = (h4[0] + h4[1]) + (h4[2] + h4[3]); unsigned incl = loc;
#pragma unroll
    for (int o = 1; o < 64; o <<= 1) { const unsigned v = (unsigned)__shfl_up((int)incl, o); if (lane >= o) incl += v; }
    const unsigned excl = incl - loc;
    const unsigned long long crossm = __ballot(excl < need && incl >= need);
    const int cl = __builtin_ctzll(crossm);
    unsigned c = excl, bst = 0u, nc = 0u, above = 0u; bool fnd = false;
#pragma unroll
    for (int k = 3; k >= 0; --k) { if (!fnd) { if (c + h4[k] >= need) { bst = (unsigned)(252 - 4 * lane + k); nc = h4[k]; above = c; fnd = true; } else c += h4[k]; } }
    bstar = (unsigned)__builtin_amdgcn_readlane((int)bst, cl) + 1u; ncand = (unsigned)__builtin_amdgcn_readlane((int)nc, cl); need -= (unsigned)__builtin_amdgcn_readlane((int)above, cl);
}
template <int NREG>
__device__ __forceinline__ bool hist_refine(unsigned (&breg)[NREG], const ALAS float* Sr, int lane, unsigned bstar, float& tie_v) {
    float mn = INFINITY, mx = -INFINITY;
#pragma unroll
    for (int i = 0; i < NREG; ++i) { const float f = Sr[64 * i + lane]; const bool in = (breg[i] == bstar); mn = fminf(mn, in ? f : INFINITY); mx = fmaxf(mx, in ? f : -INFINITY); }
    const float lo = wave_minf(mn), hi = wave_maxf(mx);
    if (!(hi > lo)) { tie_v = lo; return false; }
    const float scale = 255.5f / (hi - lo);
#pragma unroll
    for (int i = 0; i < NREG; ++i) { const unsigned b = (unsigned)((Sr[64 * i + lane] - lo) * scale); breg[i] = (breg[i] == bstar) ? (b > 255u ? 255u : b) + 1u : (breg[i] > bstar ? 0xFFFFFFFFu : 0u); }
    return true;
}
template <int I, int NREG> __device__ __forceinline__ void fin_words(const unsigned (&breg)[NREG], unsigned bstar, unsigned& wlo, unsigned& whi) {
    if constexpr (I < NREG) { const unsigned long long w = __ballot(breg[I] > bstar); wlane<I>(wlo, (unsigned)w); wlane<I>(whi, (unsigned)(w >> 32)); fin_words<I + 1, NREG>(breg, bstar, wlo, whi); }
}
template <int NREG>
__device__ __forceinline__ int select_hist(const ALAS float* Sr, int t, unsigned kmin, unsigned kmax, unsigned long long* bm, ALAS unsigned char* wl, int lane, float& tie_v) {
    ALAS unsigned* hist = (ALAS unsigned*)wl; ALAS unsigned* ckey = hist; ALAS unsigned short* cpos = (ALAS unsigned short*)(hist + 256); ALAS unsigned long long* mk64 = (ALAS unsigned long long*)(wl + 1536); ALAS unsigned* mk32 = (ALAS unsigned*)mk64;
    const float lo = unsortable(kmin), hi = unsortable(kmax);
    if (!(hi > lo)) { tie_v = lo; return 2; }
    unsigned breg[NREG];
    { const float scale = 255.5f / (hi - lo);
#pragma unroll
      for (int i = 0; i < NREG; ++i) { const unsigned b = (unsigned)((Sr[64 * i + lane] - lo) * scale); breg[i] = (64 * i + lane <= t) ? (b > 255u ? 255u : b) + 1u : 0u; } }
    unsigned wlo = 0u, whi = 0u, need = 256u, bstar = 0u, ncand = 0u;
    hist_level<NREG>(breg, hist, lane, need, bstar, ncand);
    if (ncand > 256u) { if (!hist_refine<NREG>(breg, Sr, lane, bstar, tie_v)) return 2; hist_level<NREG>(breg, hist, lane, need, bstar, ncand);
        if (ncand > 256u) { if (!hist_refine<NREG>(breg, Sr, lane, bstar, tie_v)) return 2; hist_level<NREG>(breg, hist, lane, need, bstar, ncand); if (ncand > 256u) return 1; } }
    fin_words<0, NREG>(breg, bstar, wlo, whi);
    if (lane < 32) mk64[lane] = ((unsigned long long)whi << 32) | wlo;
    unsigned base = 0u;
#pragma unroll
    for (int i = 0; i < NREG; ++i) {
        const unsigned long long eq = __ballot(breg[i] == bstar);
        if (eq != 0ull) { const unsigned pos = base + (unsigned)__builtin_amdgcn_mbcnt_hi((unsigned)(eq >> 32), __builtin_amdgcn_mbcnt_lo((unsigned)eq, 0u));
            if (breg[i] == bstar) { ckey[pos] = sortable(Sr[64 * i + lane]); cpos[pos] = (unsigned short)(64 * i + lane); }
            base += (unsigned)__builtin_popcountll(eq); } }
    unsigned ck[4], cp[4];
#pragma unroll
    for (int j = 0; j < 4; ++j) { const bool in = (64 * j + lane < (int)ncand); ck[j] = in ? ckey[64 * j + lane] : 0u; cp[j] = in ? (unsigned)cpos[64 * j + lane] : 0u; }
    unsigned T = 0u;
#pragma unroll 1
    for (int bit = 31; bit >= 0; --bit) { const unsigned x = T | (1u << bit);
        unsigned c = (unsigned)__builtin_popcountll(__ballot(ck[0] >= x));
        if (ncand > 64u) c += (unsigned)__builtin_popcountll(__ballot(ck[1] >= x)) + (unsigned)__builtin_popcountll(__ballot(ck[2] >= x)) + (unsigned)__builtin_popcountll(__ballot(ck[3] >= x));
        if (c >= need) T = x;
        if (c == need) break; }
    int need_eq = (int)need;
#pragma unroll
    for (int j = 0; j < 4; ++j) need_eq -= __builtin_popcountll(__ballot(ck[j] > T));
#pragma unroll
    for (int j = 0; j < 4; ++j) { const unsigned long long eqc = __ballot(ck[j] == T && 64 * j + lane < (int)ncand);
        const int rk = __builtin_amdgcn_mbcnt_hi((unsigned)(eqc >> 32), __builtin_amdgcn_mbcnt_lo((unsigned)eqc, 0u));
        if (64 * j + lane < (int)ncand && (ck[j] > T || (ck[j] == T && rk < need_eq))) __hip_atomic_fetch_or(mk32 + (cp[j] >> 5), 1u << (cp[j] & 31u), __ATOMIC_RELAXED, __HIP_MEMORY_SCOPE_WORKGROUP);
        need_eq -= __builtin_popcountll(eqc); }
    if (lane < 32) bm[lane] = mk64[lane];
    return 0;
}
template <int I, int NREG> __device__ __forceinline__ void ties_words(const ALAS float* Sr, int t, float v, int rem, int lane, unsigned& wlo, unsigned& whi) {
    if constexpr (I < NREG) { const float f = Sr[64 * I + lane]; const bool ok = (64 * I + lane <= t);
        const unsigned long long eq = __ballot(ok && f == v);
        const int rk = __builtin_amdgcn_mbcnt_hi((unsigned)(eq >> 32), __builtin_amdgcn_mbcnt_lo((unsigned)eq, 0u));
        const unsigned long long w = __ballot(ok && (f > v || (f == v && rk < rem)));
        wlane<I>(wlo, (unsigned)w); wlane<I>(whi, (unsigned)(w >> 32));
        const int take = __builtin_popcountll(eq); ties_words<I + 1, NREG>(Sr, t, v, rem > take ? rem - take : 0, lane, wlo, whi); }
}
template <int NREG>
__device__ __forceinline__ void select_ties(const ALAS float* Sr, int t, float v, unsigned long long* bm, int lane) {
    unsigned c = 0u;
#pragma unroll
    for (int i = 0; i < NREG; ++i) c += (64 * i + lane <= t && Sr[64 * i + lane] > v) ? 1u : 0u;
    const int rem = 256 - (int)wave_sum_u32(c);
    unsigned wlo = 0u, whi = 0u;
    ties_words<0, NREG>(Sr, t, v, rem, lane, wlo, whi);
    if (lane < 32) bm[lane] = ((unsigned long long)whi << 32) | wlo;
}
template <int NREG>
__device__ __forceinline__ void select_rows(const ALAS float* Sa, const ALAS float* Sb, int ta, unsigned long long* bm0, ALAS unsigned char* wl, int lane, int nreg, const ALAS unsigned* RMNr) {
    const unsigned kmna = RMNr[0] + 1u, kmxa = RMNr[16], kmnb = RMNr[1] + 1u, kmxb = RMNr[17];
    float va = 0.f, vb = 0.f;
    const int ra = select_hist<NREG>(Sa, ta, kmna, kmxa, bm0, wl, lane, va);
    const int rb = select_hist<NREG>(Sb, ta + 1, kmnb, kmxb, bm0 + 32, wl, lane, vb);
    if (ra == 2) select_ties<NREG>(Sa, ta, va, bm0, lane);
    if (rb == 2) select_ties<NREG>(Sb, ta + 1, vb, bm0 + 32, lane);
    if (ra == 1 || rb == 1) select2<NREG>(Sa, Sb, ta, bm0, bm0 + 32, lane, 80, nreg, RMNr);
}
__device__ __forceinline__ void idx_unit(int b, int qb16, const bf16_t* PO, const float* WI, unsigned long long* BM, ALAS unsigned char* lds, int probe = 0) {
    const int tid = threadIdx.x, lane = tid & 63, wave = __builtin_amdgcn_readfirstlane(tid >> 6), fr = lane & 15, fq = lane >> 4;
    const int t0 = qb16 * 16, tok0 = b * 2048, nk = t0 + 16, nt16 = qb16 + 1;
    unsigned long long* bm0 = BM + (size_t)(tok0 + t0 + 2 * wave) * 32;
    if (qb16 < 16) {
#pragma unroll 1
        for (int rr = 0; rr < 2; ++rr) { const int t = t0 + 2 * wave + rr;
            if (lane < 32) { const int base = 64 * lane; unsigned long long w = 0ull; if (t >= base + 63) w = ~0ull; else if (t >= base) w = (2ull << (t - base)) - 1ull; bm0[rr * 32 + lane] = w; } }
        return;
    }
    ALAS float* S = (ALAS float*)lds; ALAS unsigned* SU = (ALAS unsigned*)lds;
    ALAS unsigned* RMN = (ALAS unsigned*)(lds + 16 * SROW * 4); ALAS unsigned* RMX = RMN + 16;
    if (tid < 16) { RMN[tid] = 0xFFFFFFFFu; RMX[tid] = 0u; }
    __syncthreads();
    {
        unsigned mnk[4] = {0xFFFFFFFFu, 0xFFFFFFFFu, 0xFFFFFFFFu, 0xFFFFFFFFu}, mxk[4] = {0u, 0u, 0u, 0u};
        bf16x8 qa[8]; const bf16_t* qp = PO + (size_t)(tok0 + t0 + fr) * 1536 + 768 + fq * 8;
#pragma unroll
        for (int h = 0; h < 8; ++h) qa[h] = *(const bf16x8*)(qp + h * 32);
        float wv[4][8];
#pragma unroll
        for (int i = 0; i < 4; ++i) { const f32x4 w0 = *(const f32x4*)(WI + (size_t)(tok0 + t0 + 4 * fq + i) * 8), w1 = *(const f32x4*)(WI + (size_t)(tok0 + t0 + 4 * fq + i) * 8 + 4);
#pragma unroll
            for (int e = 0; e < 4; ++e) { wv[i][e] = w0[e]; wv[i][4 + e] = w1[e]; } }
        const bf16_t* kbase = PO + (size_t)(tok0 + fr) * 1536 + 1280 + fq * 8;
#pragma unroll 1
        for (int j0 = wave; j0 < nt16; j0 += 32) {
            bf16x8 kf[4];
#pragma unroll
            for (int c = 0; c < 4; ++c) { const int j = j0 + 8 * c, jc = j < nt16 ? j : nt16 - 1; kf[c] = *(const bf16x8*)(kbase + (size_t)(16 * jc) * 1536); }
#pragma unroll
            for (int c = 0; c < 4; ++c) { const int j = j0 + 8 * c;
                f32x4 sc = {0.f, 0.f, 0.f, 0.f};
#pragma unroll
                for (int h = 0; h < 8; ++h) { const f32x4 d = __builtin_amdgcn_mfma_f32_16x16x32_bf16(qa[h], kf[c], (f32x4){0.f, 0.f, 0.f, 0.f}, 0, 0, 0);
#pragma unroll
                    for (int i = 0; i < 4; ++i) sc[i] += fmaxf(d[i], 0.f) * wv[i][h]; }
                if (j < nt16) {
#pragma unroll
                    for (int i = 0; i < 4; ++i) { unsigned kx = sortable(sc[i]); if (16 * j + fr > t0 + 4 * fq + i) kx = 0u;
                        S[(4 * fq + i) * SROW + 16 * j + fr] = sc[i]; mnk[i] = min(mnk[i], kx - 1u); mxk[i] = max(mxk[i], kx); } } }
        }
#pragma unroll
        for (int i = 0; i < 4; ++i) { unsigned a = mnk[i], b = mxk[i];
#pragma unroll
            for (int o = 1; o < 16; o <<= 1) { a = min(a, (unsigned)__shfl_xor((int)a, o)); b = max(b, (unsigned)__shfl_xor((int)b, o)); }
            if (fr == 0) { __hip_atomic_fetch_min(RMN + 4 * fq + i, a, __ATOMIC_RELAXED, __HIP_MEMORY_SCOPE_WORKGROUP); __hip_atomic_fetch_max(RMX + 4 * fq + i, b, __ATOMIC_RELAXED, __HIP_MEMORY_SCOPE_WORKGROUP); } }
    }
    __syncthreads();
    if (!(probe & 4)) { const int r = 2 * wave, nreg = (nk + 63) >> 6; const ALAS float* Sa = S + r * SROW; const ALAS float* Sb = Sa + SROW;
      ALAS unsigned char* wl = lds + 16 * SROW * 4 + 128 + wave * 1792;
      if (nreg <= 8) select_rows<8>(Sa, Sb, t0 + r, bm0, wl, lane, nreg, RMN + r);
      else if (nreg <= 16) select_rows<16>(Sa, Sb, t0 + r, bm0, wl, lane, nreg, RMN + r);
      else if (nreg <= 24) select_rows<24>(Sa, Sb, t0 + r, bm0, wl, lane, nreg, RMN + r);
      else select_rows<32>(Sa, Sb, t0 + r, bm0, wl, lane, nreg, RMN + r); }
    __syncthreads();
}
#undef ALAS
}

constexpr int NWAVES = 8;
#ifndef MK_N_LAUNCHES
#define MK_N_LAUNCHES 1
#endif
constexpr int NPHASE = 13;
constexpr int N_LAUNCHES = MK_N_LAUNCHES;

constexpr int SEQ = 2048, NB = 16, M = NB * SEQ, D = 1024, FF = 4096;
constexpr int NE = 2304;
constexpr int NO = 1536;
constexpr float C2_64 = 0.125f * 1.4426950408889634f;
constexpr float C2_96 = 0.10206207261596577f * 1.4426950408889634f;

constexpr size_t MiB = 1u << 20;
constexpr size_t WS_CTL = 0, CTL_ZERO_BYTES = 64 * 1024;
constexpr size_t WS_ROPE = 1 * MiB;
constexpr size_t WS_BIAS = WS_ROPE + 256 * 1024;
constexpr size_t WS_FA = WS_BIAS + 64 * 1024;
constexpr size_t WS_F2 = WS_FA + 1 * MiB;
constexpr size_t WS_WI = WS_F2 + 1 * MiB;
constexpr size_t WS_SSQ = WS_WI + 1 * MiB;
constexpr size_t WS_SSKV = WS_SSQ + 512 * 1024;
constexpr size_t WS_SSA = 6 * MiB;
constexpr size_t WS_SSB = 8 * MiB;
constexpr size_t WS_W = 10 * MiB;
constexpr size_t W_INE = WS_W;
constexpr size_t W_OUTE = W_INE + (size_t)NE * D * 2;
constexpr size_t W_M1A = W_OUTE + (size_t)D * D * 2;
constexpr size_t W_M2A = W_M1A + (size_t)FF * D * 2;
constexpr size_t W_INO = W_M2A + (size_t)FF * D * 2;
constexpr size_t W_UQ = W_INO + (size_t)NO * D * 2;
constexpr size_t W_UKV = W_UQ + (size_t)768 * 256 * 2;
constexpr size_t W_OUTO = W_UKV + (size_t)1024 * 128 * 2;
constexpr size_t W_M1B = W_OUTO + (size_t)D * D * 2;
constexpr size_t W_M2B = W_M1B + (size_t)FF * D * 2;
constexpr size_t W_END = W_M2B + (size_t)FF * D * 2;
constexpr size_t WS_XB = 56 * MiB;
constexpr size_t WS_BIG = 120 * MiB;
constexpr size_t WS_PE = WS_BIG;
constexpr size_t WS_OE = WS_BIG + 144 * MiB;
constexpr size_t WS_H = WS_BIG;
constexpr size_t WS_PO = WS_BIG;
constexpr size_t WS_QD = WS_BIG + 96 * MiB;
constexpr size_t WS_KD = WS_BIG + 144 * MiB;
constexpr size_t WS_VD = WS_BIG + 192 * MiB;
constexpr size_t WS_OO = WS_BIG + 256 * MiB;
constexpr size_t WS_BM = WS_OO + 64 * MiB;
constexpr size_t WS_END = WS_BM + 8 * MiB;
static_assert(W_END <= WS_XB && WS_SSKV + 512 * 1024 <= WS_SSA, "d_ws map");
constexpr int CW_BAR = 1024;

constexpr int RING_BYTES = 131072;
constexpr int LDS_SCRATCH = 145920;
constexpr int LDSCTL_OFF = LDS_SCRATCH, MISC_OFF = LDSCTL_OFF + 320;
constexpr int LDS_BYTES = 147456;

#define GAS __attribute__((address_space(1)))
#define LAS __attribute__((address_space(3)))
typedef unsigned short bf16;
typedef unsigned v4u __attribute__((ext_vector_type(4)));
typedef float f32x4 __attribute__((ext_vector_type(4)));
typedef short bf16x8 __attribute__((ext_vector_type(8)));
typedef GAS unsigned gu32;
typedef GAS unsigned long long gu64;
#define RLX_AGENT __ATOMIC_RELAXED, __HIP_MEMORY_SCOPE_AGENT
#define LDS_WAIT() asm volatile("s_waitcnt lgkmcnt(0)" ::: "memory")
#define VM_WAIT() asm volatile("s_waitcnt vmcnt(0)" ::: "memory")
__device__ __forceinline__ unsigned long long rt() { return __builtin_amdgcn_s_memrealtime(); }
__device__ __forceinline__ unsigned f2bf(float f) { unsigned u = __builtin_bit_cast(unsigned, f); return (u + 0x7fffu + ((u >> 16) & 1u)) >> 16; }
__device__ __forceinline__ unsigned pk2(float lo, float hi) { return f2bf(lo) | (f2bf(hi) << 16); }

#define XB_TMO      128
#define XB_XCNT(j)  (256  + 64 * (j))
#define XB_XSUB(j)  (1280 + 64 * (j))
#define XB_XGEN(j)  (2304 + 64 * (j))
#define XB_TOP      3328
#define XB_TOPGEN   3392
#define XCD_BAR_WORDS 3456
#define XB_SPIN_CAP (1u << 18)

__device__ __forceinline__ unsigned xb_ld(unsigned* p)              { return __hip_atomic_load(p, __ATOMIC_RELAXED, __HIP_MEMORY_SCOPE_AGENT); }
__device__ __forceinline__ unsigned xb_add(unsigned* p, unsigned v) { return __hip_atomic_fetch_add(p, v, __ATOMIC_RELAXED, __HIP_MEMORY_SCOPE_AGENT); }
__device__ __forceinline__ unsigned xb_xcc_id() { return (unsigned)__builtin_amdgcn_s_getreg((3 << 11) | 20) & 0xFu; }
#define XB_SPIN(cond, bar) do { unsigned _sp = 0; while (cond) { __builtin_amdgcn_s_sleep(1); \
    if ((++_sp & 255u) == 0u) { if (xb_ld(&(bar)[XB_TMO])) break; if (_sp > XB_SPIN_CAP) { atomicAdd(&(bar)[XB_TMO], 1u); break; } } } } while (0)

struct XcdBarrier {
    unsigned* bar; unsigned x;
    volatile LAS unsigned* st;
};

__device__ __forceinline__ XcdBarrier xcd_barrier_post(unsigned* bar, volatile LAS unsigned* st) {
    XcdBarrier b; b.bar = bar; b.x = xb_xcc_id(); b.st = st;
    if (threadIdx.x == 0) (void)xb_add(&bar[XB_XCNT(b.x)], 1u);
    return b;
}
__device__ __forceinline__ void xcd_barrier_complete(unsigned* bar, unsigned x, unsigned& nloc, unsigned& nx) {
    const unsigned G = gridDim.x * gridDim.y * gridDim.z;
    unsigned sum, cnt, mine, sp = 0u;
    for (;;) {
        sum = 0u; cnt = 0u; mine = 0u;
#pragma unroll
        for (unsigned j = 0; j < 16; ++j) { const unsigned c = xb_ld(&bar[XB_XCNT(j)]); sum += c; cnt += (c > 0u) ? 1u : 0u; mine = (j == x) ? c : mine; }
        if (sum == G) break;
        __builtin_amdgcn_s_sleep(1);
        if ((++sp & 255u) == 0u) { if (xb_ld(&bar[XB_TMO])) break; if (sp > XB_SPIN_CAP) { atomicAdd(&bar[XB_TMO], 1u); break; } }
    }
    nloc = mine > 0u ? mine : 1u; nx = cnt > 0u ? cnt : 1u;
}

__device__ __forceinline__ void xcd_barrier(const XcdBarrier& b) {
    asm volatile("s_waitcnt vmcnt(0)" ::: "memory");
    __syncthreads();
    if (threadIdx.x == 0) {
        unsigned* bar = b.bar;
        __builtin_amdgcn_s_waitcnt(0);
        unsigned nloc = b.st[0], nx = b.st[1];
        if (nloc == 0u) { xcd_barrier_complete(bar, b.x, nloc, nx); b.st[0] = nloc; b.st[1] = nx; }
        const unsigned old = xb_add(&bar[XB_XSUB(b.x)], 1u);
        const unsigned gen = old / nloc;
        if (old + 1u == (gen + 1u) * nloc) {
            __builtin_amdgcn_fence(__ATOMIC_RELEASE, "agent");
            asm volatile("s_waitcnt vmcnt(0)" ::: "memory");
            const unsigned og = xb_add(&bar[XB_TOP], 1u);
            const unsigned tg = og / nx;
            if (og + 1u == (tg + 1u) * nx) xb_add(&bar[XB_TOPGEN], 1u);
            else XB_SPIN(xb_ld(&bar[XB_TOPGEN]) == tg, bar);
            __builtin_amdgcn_fence(__ATOMIC_ACQUIRE, "agent");
            xb_add(&bar[XB_XGEN(b.x)], 1u);
            asm volatile("s_waitcnt vmcnt(0)" ::: "memory");
        } else {
            XB_SPIN(xb_ld(&bar[XB_XGEN(b.x)]) == gen, bar);
            __builtin_amdgcn_fence(__ATOMIC_ACQUIRE, "agent");
            asm volatile("s_waitcnt vmcnt(0)" ::: "memory");
        }
    }
    __syncthreads();
}

__device__ __forceinline__ float wave_sum(float v) {
#pragma unroll
    for (int o = 1; o < 64; o <<= 1) v += __shfl_xor(v, o);
    return v;
}
template <int WHICH> __device__ __forceinline__ int srccol(int n) {
    if (WHICH == 0) return n;
    if (WHICH == 1) return n < 1536 ? n : n + 8;
    if (n < 512) return n;
    if (n < 768) return 936 + (n - 512);
    if (n < 1024) return 640 + (n - 768);
    if (n < 1152) return 1192 + (n - 1024);
    if (n < 1216) return 512 + (n - 1152);
    if (n < 1280) return 576 + (n - 1216);
    if (n < 1312) return 896 + (n - 1280);
    if (n < 1344) return 1320 + (n - 1312);
    if (n < 1352) return 928 + (n - 1344);
    return -1;
}
template <int WHICH>
__device__ __forceinline__ void p0_transpose_item(const float* W, int K, int Nsrc, int Ndst, const float* gain, bf16* WT, LAS float* scr, int item, int lane) {
    const int nblk = Ndst / 32, kb = item / nblk, nb = item % nblk, k0 = 64 * kb, n0 = 32 * nb;
    const int sc = srccol<WHICH>(n0 + (lane & 31));
#pragma unroll
    for (int i = 0; i < 32; ++i) { const int kk = 2 * i + (lane >> 5); float v = 0.f; if (sc >= 0) { v = W[(size_t)(k0 + kk) * Nsrc + sc]; if (gain) v *= gain[k0 + kk]; } scr[kk * 33 + (lane & 31)] = v; }
    LDS_WAIT(); asm volatile("" ::: "memory");
    const int c = lane & 7;
#pragma unroll
    for (int j = 0; j < 4; ++j) { const int n = (lane >> 3) + 8 * j; const LAS float* s = scr + (8 * c) * 33 + n;
        v4u o; o.x = pk2(s[0 * 33], s[1 * 33]); o.y = pk2(s[2 * 33], s[3 * 33]); o.z = pk2(s[4 * 33], s[5 * 33]); o.w = pk2(s[6 * 33], s[7 * 33]);
        *(GAS v4u*)(WT + (size_t)(n0 + n) * K + k0 + 8 * c) = o; }
    LDS_WAIT(); asm volatile("" ::: "memory");
}
struct TrSrc { const float* W; const float* gain; bf16* WT; int K, Nsrc, Ndst, which, item; };
__device__ __forceinline__ int srccol_rt(int which, int n) { return which == 2 ? srccol<2>(n) : n; }
__device__ __forceinline__ void tr_issue(const TrSrc& t, LAS unsigned char* tile, int lane) {
    const int nblk = t.Ndst / 32, kb = t.item / nblk, nb = t.item % nblk, k0 = 64 * kb, n0 = 32 * nb;
    const int sc = srccol_rt(t.which, n0 + 4 * (lane & 7));
    const float* src = t.W + (size_t)(k0 + (lane >> 3)) * t.Nsrc + (sc < 0 ? 0 : sc);
    if (sc >= 0) {
#pragma unroll
        for (int i = 0; i < 8; ++i) __builtin_amdgcn_global_load_lds((const GAS unsigned*)(src + (size_t)(8 * i) * t.Nsrc), (LAS unsigned*)(tile + i * 1024), 16, 0, 0);
    }
}
__device__ __forceinline__ void tr_finish(const TrSrc& t, const LAS unsigned char* tile, int lane) {
    const int nblk = t.Ndst / 32, kb = t.item / nblk, nb = t.item % nblk, k0 = 64 * kb, n0 = 32 * nb;
    asm volatile("s_waitcnt vmcnt(0)" ::: "memory");
    const int c = lane & 7; const LAS float* tl = (const LAS float*)tile;
    f32x4 g0 = {1.f, 1.f, 1.f, 1.f}, g1 = {1.f, 1.f, 1.f, 1.f};
    if (t.gain) { g0 = *(const f32x4*)(t.gain + k0 + 8 * c); g1 = *(const f32x4*)(t.gain + k0 + 8 * c + 4); }
#pragma unroll
    for (int j = 0; j < 4; ++j) { const int n = (lane >> 3) + 8 * j; const LAS float* s = tl + (8 * c) * 32 + n; const bool z = srccol_rt(t.which, n0 + n) < 0;
        v4u o; o.x = pk2(s[0] * g0[0], s[32] * g0[1]); o.y = pk2(s[64] * g0[2], s[96] * g0[3]); o.z = pk2(s[128] * g1[0], s[160] * g1[1]); o.w = pk2(s[192] * g1[2], s[224] * g1[3]);
        if (z) o = (v4u){0u, 0u, 0u, 0u};
        *(GAS v4u*)(t.WT + (size_t)(n0 + n) * t.K + k0 + 8 * c) = o; }
    asm volatile("s_waitcnt lgkmcnt(0)" ::: "memory");
}
__device__ __forceinline__ int t5_bucket(int n) {
    if (n < 16) return n;
    const float nf = (float)n; int large = 16 + (int)(logf(fmaxf(nf, 16.f) / 16.f) / logf(8.f) * 16.f);
    return large < 31 ? large : 31;
}

struct Args { const float* in[18]; float* out; unsigned char* ws; int ph_lo, ph_hi, li, pad; };
__global__ void __launch_bounds__(NWAVES * 64, 2) fwd_kernel(Args args) {
    extern __shared__ __attribute__((aligned(16))) unsigned char lds_raw[];
    LAS unsigned char* lds = (LAS unsigned char*)lds_raw;
    volatile LAS unsigned* MISC = (volatile LAS unsigned*)(lds + MISC_OFF);
    const int tid = threadIdx.x, lane = tid & 63, wave = __builtin_amdgcn_readfirstlane(tid >> 6);
    const int G = gridDim.x, bx = blockIdx.x, vcu = (G % 8 == 0) ? (bx % 8) * (G / 8) + bx / 8 : bx;
    unsigned char* ws = args.ws;
    gu32* ctl = (gu32*)(ws + WS_CTL);
    const float* x_in = args.in[0];
    float* out = args.out;
    bf16* XB = (bf16*)(ws + WS_XB); bf16* PE = (bf16*)(ws + WS_PE); bf16* OE = (bf16*)(ws + WS_OE); bf16* HB = (bf16*)(ws + WS_H);
    bf16* PO = (bf16*)(ws + WS_PO); bf16* QD = (bf16*)(ws + WS_QD); bf16* KD = (bf16*)(ws + WS_KD); bf16* VD = (bf16*)(ws + WS_VD); bf16* OO = (bf16*)(ws + WS_OO);
    unsigned long long* BMg = (unsigned long long*)(ws + WS_BM);
    float* ROPE = (float*)(ws + WS_ROPE); float* BIAS = (float*)(ws + WS_BIAS); float* FA = (float*)(ws + WS_FA); float* F2 = (float*)(ws + WS_F2); float* WI = (float*)(ws + WS_WI);
    float* SSQ = (float*)(ws + WS_SSQ); float* SSKV = (float*)(ws + WS_SSKV); float* SSA = (float*)(ws + WS_SSA); float* SSB = (float*)(ws + WS_SSB);

    for (int u = tid; u < (LDS_BYTES - LDSCTL_OFF) / 4; u += NWAVES * 64) ((LAS unsigned*)(lds + LDSCTL_OFF))[u] = 0u;
    __syncthreads();
    XcdBarrier bar; bar.bar = (unsigned*)(ctl + CW_BAR); bar.x = 0; bar.st = nullptr;
    if (N_LAUNCHES == 1) bar = xcd_barrier_post((unsigned*)(ctl + CW_BAR), MISC + 8);
#define GRID_BAR() do { if (N_LAUNCHES == 1) xcd_barrier(bar); } while (0)
    const int lo = args.ph_lo, hi = args.ph_hi;
#ifndef PH_MASK
#define PH_MASK 0x1FFF
#endif
#ifndef REP_MASK
#define REP_MASK 0
#endif
#define IN(k) ((((PH_MASK) >> (k)) & 1) && lo <= (k) && (k) < hi)
#ifndef TS_PHASE
#define TS_PHASE -1
#endif
#ifndef TS_A
#define TS_A TS_PHASE
#define TS_B (TS_PHASE + 1)
#endif
#define STAMP(k) do { if (TS_PHASE >= 0 && bx == 0 && tid == 0) ((unsigned long long*)(ctl + 512))[k] = __builtin_amdgcn_s_memrealtime(); } while (0)
#ifndef TS_BLK
#define TS_BLK 0
#endif
#define STAMPB(k) do { if (TS_PHASE >= 0 && bx == TS_BLK && tid == 0) ((unsigned long long*)(ctl + 512))[k] = __builtin_amdgcn_s_memrealtime(); } while (0)
#define SEAM(k) do { if (IN(k) && IN((k) + 1)) GRID_BAR(); STAMP((k) + 1); } while (0)
    STAMP(0);

    if (IN(0)) for (int rep_ = 0; rep_ <= ((REP_MASK >> 0) & 1); ++rep_) { if (rep_) GRID_BAR();
        LAS float* scr = (LAS float*)(lds + wave * 16384);
        const int gw = vcu * NWAVES + wave, NGW = G * NWAVES;
        const float* nmE = args.in[1]; const float* winE = args.in[2]; const float* woutE = args.in[5]; const float* nmO = args.in[6]; const float* winO = args.in[7];
        const float* ncq = args.in[8]; const float* nckv = args.in[9]; const float* wuq = args.in[10]; const float* wukv = args.in[11]; const float* woutO = args.in[12];
        const float* nmlp = args.in[13]; const float* w1 = args.in[14]; const float* w2 = args.in[15];
        constexpr int I0 = 16 * 72;
        for (int it = gw; it < I0; it += NGW) p0_transpose_item<1>(winE, 1024, 2312, NE, nmE, (bf16*)(ws + W_INE), scr, it, lane);
        STAMPB(23);
        { const int gt = vcu * (NWAVES * 64) + tid;
          if (gt < 2048 * 16) { const int pos = gt >> 4, i = gt & 15; const float inv = exp2f(-(float)i * 0.83048202372184058696f);
              const float ang = (float)pos * inv; float rev = ang * 0.15915494309189533577f; rev -= floorf(rev);
              ROPE[2 * gt] = __builtin_amdgcn_cosf(rev); ROPE[2 * gt + 1] = __builtin_amdgcn_sinf(rev); }
          if (gt < 2048) { const int which = gt >> 10, h = (gt >> 7) & 7, d = gt & 127; float v = args.in[16][t5_bucket(d) * 16 + which * 8 + h]; if (which) v -= args.in[16][31 * 16 + 8 + h]; BIAS[gt] = v * att::LOG2E; } }
        STAMPB(24);
        { float wf[16][8];
#pragma unroll
          for (int j = 0; j < 4; ++j)
#pragma unroll
              for (int e = 0; e < 4; ++e) { const int k = 256 * j + 4 * lane + e; const float gk = nmE[k];
#pragma unroll
                  for (int c = 0; c < 8; ++c) wf[j * 4 + e][c] = winE[(size_t)k * 2312 + 1536 + c] * gk; }
          f32x4 vn[4];
          if (gw < M) { const GAS f32x4* xr = (const GAS f32x4*)(x_in + (size_t)gw * D) + lane;
#pragma unroll
              for (int j = 0; j < 4; ++j) vn[j] = xr[64 * j]; }
          for (int m = gw; m < M; m += NGW) {
              f32x4 v[4]; float ss = 0.f;
#pragma unroll
              for (int j = 0; j < 4; ++j) { v[j] = vn[j]; ss += (v[j].x * v[j].x + v[j].y * v[j].y) + (v[j].z * v[j].z + v[j].w * v[j].w); }
              if (m + NGW < M) { const GAS f32x4* xr = (const GAS f32x4*)(x_in + (size_t)(m + NGW) * D) + lane;
#pragma unroll
                  for (int j = 0; j < 4; ++j) vn[j] = xr[64 * j]; }
              ss = wave_sum(ss);
              GAS unsigned long long* o8 = (GAS unsigned long long*)(XB + (size_t)m * D) + lane;
#pragma unroll
              for (int j = 0; j < 4; ++j) o8[64 * j] = (unsigned long long)pk2(v[j].x, v[j].y) | ((unsigned long long)pk2(v[j].z, v[j].w) << 32);
              float a8[8];
#pragma unroll
              for (int c = 0; c < 8; ++c) { float a = 0.f;
#pragma unroll
                  for (int j = 0; j < 4; ++j) a += (v[j].x * wf[j * 4][c] + v[j].y * wf[j * 4 + 1][c]) + (v[j].z * wf[j * 4 + 2][c] + v[j].w * wf[j * 4 + 3][c]);
                  a8[c] = a; }
              float a4[4], a2[2], a1;
              { const bool hb = (lane & 32) != 0;
#pragma unroll
                for (int i = 0; i < 4; ++i) { const float snd = hb ? a8[i] : a8[i + 4]; a4[i] = (hb ? a8[i + 4] : a8[i]) + __shfl_xor(snd, 32); } }
              { const bool hb = (lane & 16) != 0;
#pragma unroll
                for (int i = 0; i < 2; ++i) { const float snd = hb ? a4[i] : a4[i + 2]; a2[i] = (hb ? a4[i + 2] : a4[i]) + __shfl_xor(snd, 16); } }
              { const bool hb = (lane & 8) != 0; const float snd = hb ? a2[0] : a2[1]; a1 = (hb ? a2[1] : a2[0]) + __shfl_xor(snd, 8); }
              a1 += __shfl_xor(a1, 4); a1 += __shfl_xor(a1, 2); a1 += __shfl_xor(a1, 1);
              const float rstd = 1.0f / sqrtf(ss * (1.0f / 1024.0f) + 1e-6f);
              if ((lane & 7) == 0) FA[(size_t)m * 8 + (lane >> 3)] = a1 * rstd;
              if (lane < 16) SSA[(size_t)m * 16 + lane] = (lane == 0) ? ss : 0.f;
          } }
    }
    SEAM(0);
    if (IN(1)) for (int rep_ = 0; rep_ <= ((REP_MASK >> 1) & 1); ++rep_) { if (rep_) GRID_BAR();
        if (bx < 16) {
            const int b = bx, h = wave; const float bf = args.in[3][h]; float pre[32]; float run = 0.f;
#pragma unroll
            for (int i = 0; i < 32; ++i) { const float f = FA[(size_t)(b * SEQ + 32 * lane + i) * 8 + h] + bf; const float ls = fminf(f, 0.f) - log1pf(expf(-fabsf(f))); run += ls; pre[i] = run; }
            float incl = run;
#pragma unroll
            for (int o = 1; o < 64; o <<= 1) { const float t = __shfl_up(incl, o); if (lane >= o) incl += t; }
            const float excl = incl - run; float* dst = F2 + (size_t)(b * 8 + h) * SEQ + 32 * lane;
#pragma unroll
            for (int i = 0; i < 32; ++i) dst[i] = (excl + pre[i]) * att::LOG2E;
        }
        pg8::Gemm g{XB, (const bf16*)(ws + W_INE), M, NE, D, D}; pg8::StaticOrder S; S.init(M, NE, G, bx);
        pg8::EpiNormBf16<0> E{PE, NE, SSA, 0xC3u, C2_64};
        pg8::gemm_phase<pg8::EpiNormBf16<0>, pg8::StaticOrder, true, true>(lds, g, S, E);
    }
    SEAM(1);
    if (IN(2)) for (int rep_ = 0; rep_ <= ((REP_MASK >> 2) & 1); ++rep_) { if (rep_) GRID_BAR();
        for (int i = tid; i < 2048; i += NWAVES * 64) ((LAS float*)(lds + att::BIAS_LDS_OFF))[i] = BIAS[i];
        __syncthreads();
        constexpr int J1 = 16 * 32, J2 = 16 * 128, J3 = 64 * 32, J4 = 16 * 48, J5 = 4 * 24, J6 = 2 * 32, ND = J1 + J2 + J3 + J4 + J5 + J6 + J1 + J2 + J3;
        LAS unsigned char* trt = lds + 73728 + wave * 8192;
        const int trw = vcu * NWAVES + wave, trn = G * NWAVES; int trnext = trw; TrSrc trp; trp.item = -1;
#define TR_DECODE(r_, t_) do { int r = (r_); \
            if (r < J1) { t_ = TrSrc{args.in[5], nullptr, (bf16*)(ws + W_OUTE), 1024, 1024, 1024, 0, r}; break; } r -= J1; \
            if (r < J2) { t_ = TrSrc{args.in[14], args.in[13], (bf16*)(ws + W_M1A), 1024, 4096, 4096, 0, r}; break; } r -= J2; \
            if (r < J3) { t_ = TrSrc{args.in[15], nullptr, (bf16*)(ws + W_M2A), 4096, 1024, 1024, 0, r}; break; } r -= J3; \
            if (r < J4) { t_ = TrSrc{args.in[7], args.in[6], (bf16*)(ws + W_INO), 1024, 1352, NO, 2, r}; break; } r -= J4; \
            if (r < J5) { t_ = TrSrc{args.in[10], args.in[8], (bf16*)(ws + W_UQ), 256, 768, 768, 0, r}; break; } r -= J5; \
            if (r < J6) { t_ = TrSrc{args.in[11], args.in[9], (bf16*)(ws + W_UKV), 128, 1024, 1024, 0, r}; break; } r -= J6; \
            if (r < J1) { t_ = TrSrc{args.in[12], nullptr, (bf16*)(ws + W_OUTO), 1024, 1024, 1024, 0, r}; break; } r -= J1; \
            if (r < J2) { t_ = TrSrc{args.in[14] + (size_t)1024 * 4096, args.in[13] + 1024, (bf16*)(ws + W_M1B), 1024, 4096, 4096, 0, r}; break; } r -= J2; \
            t_ = TrSrc{args.in[15] + (size_t)4096 * 1024, nullptr, (bf16*)(ws + W_M2B), 4096, 1024, 1024, 0, r}; } while (0)
#define TR_STEP() do { if (trp.item >= 0) { tr_finish(trp, trt, lane); trp.item = -1; } if (trnext < ND) { TR_DECODE(trnext, trp); tr_issue(trp, trt, lane); trnext += trn; } } while (0)
        for (int p = vcu; p < 512; p += G) { const int bh = p >> 2, s = p & 3, b = bh >> 3, h = bh & 7;
            for (int z = 0; z < 2; ++z) { const int qb = z ? s : 7 - s;
                TR_STEP();
                att::AU u; u.Q = PE + h * 64; u.ldq = NE; u.K = PE + 512 + h * 64; u.ldk = NE; u.V = PE + 1024 + h * 64; u.ldv = NE; u.O = OE + h * 64; u.ldo = D;
                u.tok0 = b * SEQ; u.qpos = qb * 256 + wave * 32; u.t_lo = 0; u.t_hi = qb * 4 + 4; u.F2 = F2 + (size_t)(b * 8 + h) * SEQ; u.cb = u.F2[qb * 256];
                u.bias = nullptr; u.sink2 = 0.f; u.bm = nullptr;
                att::attn_unit<64, 0>(u, lds); } }
        for (int idx = vcu; idx < 1024; idx += G) { const int half = idx & 1, n = (idx >> 1) & 15, kvh = (idx >> 5) & 1, b = idx >> 6;
            TR_STEP();
            const int hq = kvh * 4 + half * 2 + (wave >> 2);
            att::AU u; u.Q = PE + 1536 + hq * 64; u.ldq = NE; u.K = PE + 2048 + kvh * 64; u.ldk = NE; u.V = PE + 2176 + kvh * 64; u.ldv = NE; u.O = OE + 512 + hq * 64; u.ldo = D;
            u.tok0 = b * SEQ; u.qpos = n * 128 + (wave & 3) * 32; u.t_lo = n > 0 ? 2 * n - 2 : 0; u.t_hi = 2 * n + 2; u.F2 = nullptr; u.cb = 0.f;
            u.bias = (const LAS float*)(lds + att::BIAS_LDS_OFF) + hq * 128; u.sink2 = args.in[4][hq] * att::LOG2E; u.bm = nullptr;
            att::attn_unit<64, 1>(u, lds); }
        while (trp.item >= 0 || trnext < ND) TR_STEP();
#undef TR_STEP
#undef TR_DECODE
    }
    SEAM(2);
    if (IN(3)) for (int rep_ = 0; rep_ <= ((REP_MASK >> 3) & 1); ++rep_) { if (rep_) GRID_BAR();
        pg8::Gemm g{OE, (const bf16*)(ws + W_OUTE), M, D, D, D}; pg8::StaticOrder S; S.init(M, D, G, bx);
        pg8::EpiResid E{XB, (args.pad & 32) ? OO : XB, (args.pad & 32) ? (float*)BMg : SSB};
        pg8::gemm_phase<pg8::EpiResid, pg8::StaticOrder, true, true>(lds, g, S, E);
    }
    SEAM(3);
    if (IN(4)) for (int rep_ = 0; rep_ <= ((REP_MASK >> 4) & 1); ++rep_) { if (rep_) GRID_BAR();
        pg8::Gemm g{XB, (const bf16*)(ws + W_M1A), M, FF, D, D}; pg8::StaticOrder S; S.init(M, FF, G, bx);
        pg8::EpiNormBf16<1> E{HB, FF, SSB, 0u, 1.f};
        pg8::gemm_phase<pg8::EpiNormBf16<1>, pg8::StaticOrder, true, true>(lds, g, S, E);
    }
    SEAM(4);
    if (IN(5)) for (int rep_ = 0; rep_ <= ((REP_MASK >> 5) & 1); ++rep_) { if (rep_) GRID_BAR();
        pg8::Gemm g{HB, (const bf16*)(ws + W_M2A), M, D, FF, FF}; pg8::StaticOrder S; S.init(M, D, G, bx);
        pg8::EpiResid E{XB, (args.pad & 32) ? OO : XB, (args.pad & 32) ? (float*)BMg : SSA};
        pg8::gemm_phase<pg8::EpiResid, pg8::StaticOrder, true, true>(lds, g, S, E);
    }
    SEAM(5);
    if (IN(6)) for (int rep_ = 0; rep_ <= ((REP_MASK >> 6) & 1); ++rep_) { if (rep_) GRID_BAR();
        pg8::Gemm g{XB, (const bf16*)(ws + W_INO), M, NO, D, D}; pg8::StaticOrder S; S.init(M, NO, G, bx);
        pg8::EpiInOdd E{PO, SSA, C2_64, SSQ, SSKV, KD, WI, ROPE};
        pg8::gemm_phase<pg8::EpiInOdd, pg8::StaticOrder, true, true>(lds, g, S, E);
    }
    SEAM(6);
    if (IN(7)) for (int rep_ = 0; rep_ <= ((REP_MASK >> 7) & 1); ++rep_) { if (rep_) GRID_BAR();
        if (!(args.pad & 1)) {
        { int kq_ = 256; asm volatile("" : "+s"(kq_)); pg8::Gemm g{PO + 512, (const bf16*)(ws + W_UQ), M, 768, kq_, NO}; pg8::StaticOrder S; S.init(M, 768, G, bx);
          pg8::EpiUq E{QD, SSQ, C2_96, ROPE};
          pg8::gemm_phase<pg8::EpiUq, pg8::StaticOrder, true, true>(lds, g, S, E); }
        STAMPB(20);
        { int kk_ = 128; asm volatile("" : "+s"(kk_)); pg8::Gemm g{PO + 1024, (const bf16*)(ws + W_UKV), M, 1024, kk_, NO}; pg8::StaticOrder S; S.init(M, 1024, G, bx);
          pg8::EpiUkv E{KD, VD, SSKV};
          pg8::gemm_phase<pg8::EpiUkv, pg8::StaticOrder, true, true>(lds, g, S, E); }
        STAMPB(21);
        }
        __syncthreads();
        if (!(args.pad & 2))
        for (;;) {
            if (tid == 0) MISC[16] = __hip_atomic_fetch_add((unsigned*)(ctl + 300), 1u, __ATOMIC_RELAXED, __HIP_MEMORY_SCOPE_AGENT);
            __syncthreads();
            const unsigned ui = MISC[16];
            __syncthreads();
            if (ui >= 2048u) break;
            att::idx_unit((int)(ui & 15u), 127 - (int)(ui >> 4), PO, WI, (args.pad & 8) ? (unsigned long long*)OO : BMg, lds, args.pad); }
    }
    STAMPB(22);
    SEAM(7);
    if (IN(8)) for (int rep_ = 0; rep_ <= ((REP_MASK >> 8) & 1); ++rep_) { if (rep_) GRID_BAR();
        for (int i = tid; i < 2048; i += NWAVES * 64) ((LAS float*)(lds + att::BIAS_LDS_OFF))[i] = BIAS[i];
        __syncthreads();
        for (int p = vcu; p < 512; p += G) { const int b = p >> 5, jp = p & 31;
            for (int z = 0; z < 2; ++z) { const int j = z ? jp : 63 - jp; const int hq = wave;
                att::AU u; u.Q = PO + hq * 64; u.ldq = NO; u.K = PO + 1152; u.ldk = NO; u.V = PO + 1216; u.ldv = NO; u.O = OO + hq * 64; u.ldo = D;
                u.tok0 = b * SEQ; u.qpos = 32 * j; u.t_lo = 0; u.t_hi = (j >> 1) + 1; u.F2 = nullptr; u.cb = 0.f;
                u.bias = (const LAS float*)(lds + att::BIAS_LDS_OFF) + 1024 + hq * 128; u.sink2 = 0.f; u.bm = BMg + (size_t)b * SEQ * 32;
                att::attn_unit<64, 2>(u, lds); } }
        for (int p = vcu; p < 512; p += G) { const int bh = p >> 2, s = p & 3, b = bh >> 3, h = bh & 7;
            for (int z = 0; z < 2; ++z) { const int qb = z ? s : 7 - s;
                att::AU u; u.Q = QD + h * 96; u.ldq = 768; u.K = KD + h * 96; u.ldk = 768; u.V = VD + h * 64; u.ldv = 512; u.O = OO + 512 + h * 64; u.ldo = D;
                u.tok0 = b * SEQ; u.qpos = qb * 256 + wave * 32; u.t_lo = 0; u.t_hi = qb * 4 + 4; u.F2 = nullptr; u.cb = 0.f; u.bias = nullptr; u.sink2 = 0.f; u.bm = nullptr;
                att::attn_unit<96, 3>(u, lds); } }
    }
    SEAM(8);
    if (IN(9)) for (int rep_ = 0; rep_ <= ((REP_MASK >> 9) & 1); ++rep_) { if (rep_) GRID_BAR();
        pg8::Gemm g{OO, (const bf16*)(ws + W_OUTO), M, D, D, D}; pg8::StaticOrder S; S.init(M, D, G, bx);
        pg8::EpiResid E{XB, (args.pad & 32) ? OO : XB, (args.pad & 32) ? (float*)BMg : SSB};
        pg8::gemm_phase<pg8::EpiResid, pg8::StaticOrder, true, true>(lds, g, S, E);
    }
    SEAM(9);
    if (IN(10)) for (int rep_ = 0; rep_ <= ((REP_MASK >> 10) & 1); ++rep_) { if (rep_) GRID_BAR();
        pg8::Gemm g{XB, (const bf16*)(ws + W_M1B), M, FF, D, D}; pg8::StaticOrder S; S.init(M, FF, G, bx);
        pg8::EpiNormBf16<1> E{HB, FF, SSB, 0u, 1.f};
        pg8::gemm_phase<pg8::EpiNormBf16<1>, pg8::StaticOrder, true, true>(lds, g, S, E);
    }
    SEAM(10);
    if (IN(11)) for (int rep_ = 0; rep_ <= ((REP_MASK >> 11) & 1); ++rep_) { if (rep_) GRID_BAR();
        pg8::Gemm g{HB, (const bf16*)(ws + W_M2B), M, D, FF, FF}; pg8::StaticOrder S; S.init(M, D, G, bx);
        pg8::EpiResid E{XB, (args.pad & 32) ? OO : XB, (args.pad & 32) ? (float*)BMg : SSA};
        pg8::gemm_phase<pg8::EpiResid, pg8::StaticOrder, true, true>(lds, g, S, E);
    }
    SEAM(11);
    if (IN(12)) for (int rep_ = 0; rep_ <= ((REP_MASK >> 12) & 1); ++rep_) { if (rep_) GRID_BAR();
        const int gw = vcu * NWAVES + wave, NGW = G * NWAVES; const float* gf = args.in[17];
        f32x4 gv[4];
#pragma unroll
        for (int j = 0; j < 4; ++j) gv[j] = *((const f32x4*)gf + lane + 64 * j);
        for (int m = gw; m < M; m += NGW) {
            float s = (lane < 16) ? SSA[(size_t)m * 16 + lane] : 0.f; s = wave_sum(s);
            const float rstd = 1.0f / sqrtf(s * (1.0f / 1024.0f) + 1e-6f);
            const GAS unsigned long long* xr = (const GAS unsigned long long*)(XB + (size_t)m * D) + lane;
            GAS f32x4* orow = (GAS f32x4*)(out + (size_t)m * D) + lane;
#pragma unroll
            for (int j = 0; j < 4; ++j) { const unsigned long long w = xr[64 * j]; const unsigned lo = (unsigned)w, hi = (unsigned)(w >> 32);
                f32x4 v = {__uint_as_float(lo << 16), __uint_as_float(lo & 0xFFFF0000u), __uint_as_float(hi << 16), __uint_as_float(hi & 0xFFFF0000u)};
                orow[64 * j] = v * rstd * gv[j]; }
        }
    }
    if (TS_PHASE >= 0 && N_LAUNCHES == 1) {
        GRID_BAR();
        if (bx == 0 && tid == 0) { unsigned long long* ts_ = (unsigned long long*)(ctl + 512); ts_[13] = __builtin_amdgcn_s_memrealtime(); out[0] += (float)(ts_[TS_B] - ts_[TS_A]) * 0.0001f; }
    }
#undef IN
#undef SEAM
#undef GRID_BAR
}

extern "C" void kernel_launch(void* const* d_in, const int* in_sizes, int n_in, void* d_out, int out_size, void* d_ws, size_t ws_size, hipStream_t stream) {
    static int grid = 0;
    if (grid == 0) {
        if (n_in != 18 || in_sizes[0] != M * D || out_size != M * D || ws_size < WS_END) { fprintf(stderr, "kernel_launch: shape/workspace mismatch: n_in %d in0 %d out %d ws %zu (need %zu)\n", n_in, n_in > 0 ? in_sizes[0] : -1, out_size, ws_size, (size_t)WS_END); grid = -1; return; }
        int dev = 0, cus = 0, per_cu = 0;
        if (hipGetDevice(&dev) != hipSuccess || hipDeviceGetAttribute(&cus, hipDeviceAttributeMultiprocessorCount, dev) != hipSuccess) { fprintf(stderr, "kernel_launch: device query failed\n"); grid = -1; return; }
        if (hipFuncSetAttribute((const void*)fwd_kernel, hipFuncAttributeMaxDynamicSharedMemorySize, LDS_BYTES) != hipSuccess) { fprintf(stderr, "kernel_launch: hipFuncSetAttribute failed\n"); grid = -1; return; }
        if (hipOccupancyMaxActiveBlocksPerMultiprocessor(&per_cu, (const void*)fwd_kernel, NWAVES * 64, LDS_BYTES) != hipSuccess || per_cu < 1) { fprintf(stderr, "kernel_launch: occupancy query reports %d blocks per CU\n", per_cu); (void)hipGetLastError(); per_cu = 1; }
        grid = cus;
    }
    if (grid < 0) return;
    if (hipMemsetAsync((char*)d_ws + WS_CTL, 0, CTL_ZERO_BYTES, stream) != hipSuccess) { fprintf(stderr, "kernel_launch: memset failed\n"); return; }
    Args a{};
    for (int i = 0; i < 18; ++i) a.in[i] = (const float*)d_in[i];
    a.out = (float*)d_out; a.ws = (unsigned char*)d_ws;
#ifndef PROBE_DUP
#define PROBE_DUP -1
#endif
    for (int li = 0; li < N_LAUNCHES; ++li) {
        a.ph_lo = (N_LAUNCHES == 1) ? 0 : li; a.ph_hi = (N_LAUNCHES == 1) ? NPHASE : li + 1; a.li = li;
#ifndef PROBE_SUB
#define PROBE_SUB 0
#endif
        if (N_LAUNCHES != 1 && li == PROBE_DUP) { a.pad = PROBE_SUB; hipLaunchKernelGGL(fwd_kernel, dim3(grid), dim3(NWAVES * 64), LDS_BYTES, stream, a); a.pad = 0; }
        hipLaunchKernelGGL(fwd_kernel, dim3(grid), dim3(NWAVES * 64), LDS_BYTES, stream, a);
        const hipError_t le = hipPeekAtLastError();
        if (le != hipSuccess) { fprintf(stderr, "kernel_launch: launch %d failed: %s\n", li, hipGetErrorName(le)); break; }
    }
}
```

```cpp
#include <hip/hip_runtime.h>
#include <hip/hip_bf16.h>
#include <cstdio>
#include <cstdint>
#include <cmath>
namespace pg8 {
#define PG8_LAS __attribute__((address_space(3)))
typedef unsigned short bf16_t;
typedef short bf16x8 __attribute__((ext_vector_type(8)));
typedef float f32x4 __attribute__((ext_vector_type(4)));
typedef unsigned u32x4 __attribute__((ext_vector_type(4)));
constexpr int BM = 256, BK = 64, HALF = 128, HTB = HALF * BK * 2  , STAGE_BYTES = 8 * HTB, NXCD = 8, WGM = 8;

__host__ __device__ __forceinline__ int lds_byte(int r, int c) { const int st = (r >> 4) * 2 + (c >> 5), rr = r & 15, cc = c & 31, ob = rr * 64 + cc * 2; return st * 1024 + (ob ^ (((ob >> 9) & 1) << 5)); }
__host__ __device__ __forceinline__ void stage_rc(int b, int& R, int& C) { const int st = b / 1024, sb = b % 1024, swz = sb ^ (((sb >> 9) & 1) << 5); R = (st >> 1) * 16 + swz / 64; C = (st & 1) * 32 + (swz % 64) / 2; }
__host__ __device__ __forceinline__ int perm32(int rho) { const int n = rho >> 4, i = rho & 15; return 8 * (i >> 2) + 4 * n + (i & 3); }

struct Unit { int pm, pn; };
struct Gemm { const bf16_t* A; const bf16_t* Bt; int M, N, K, lda; };

struct StaticOrder {
    int nM, nN, nwg, G, c;
    __host__ __device__ void init(int M, int N, int G_, int c_) { nM = M / BM; nN = N / BM; nwg = nM * nN; G = G_; c = c_; }
    __host__ __device__ bool next(int i, Unit& u) const {
        const long L = (long)i * G + c; if (L >= nwg) return false;
        int wgid = (int)L; { const int q = nwg / NXCD, r = nwg % NXCD, xcd = wgid % NXCD, off = wgid / NXCD; wgid = (xcd < r ? xcd * (q + 1) : r * (q + 1) + (xcd - r) * q) + off; }
        const int nig = WGM * nN, gid = wgid / nig, fm = gid * WGM, gsz = (nM - fm) < WGM ? (nM - fm) : WGM;
        u.pm = fm + ((wgid % nig) % gsz); u.pn = (wgid % nig) / gsz; return true;
    }
    __device__ __forceinline__ void a_ready(const Unit&) const {}
    __device__ __forceinline__ void done(const Unit&) const {}
};


typedef unsigned u32x2 __attribute__((ext_vector_type(2)));
typedef float f32x2e __attribute__((ext_vector_type(2)));
typedef __bf16 bf16x2e __attribute__((ext_vector_type(2)));
__device__ __forceinline__ unsigned cvt2(float lo, float hi) { f32x2e v = {lo, hi}; bf16x2e b = __builtin_convertvector(v, bf16x2e); return __builtin_bit_cast(unsigned, b); }
__device__ __forceinline__ u32x4 pack8(const f32x4 a, const f32x4 b) { u32x4 w; w.x = cvt2(a[0], a[1]); w.y = cvt2(a[2], a[3]); w.z = cvt2(b[0], b[1]); w.w = cvt2(b[2], b[3]); return w; }
constexpr float RMS_EPS = 1e-6f;
__device__ __forceinline__ float row_rstd16(const float* ssP, int row, int fq, float invn) {
    const f32x4 p = *(const f32x4*)(ssP + (size_t)row * 16 + 4 * fq); float s = (p[0] + p[1]) + (p[2] + p[3]);
    s += __shfl_xor(s, 16); s += __shfl_xor(s, 32); return 1.0f / sqrtf(s * invn + RMS_EPS);
}
__device__ __forceinline__ float row_rstd4(const float* ssP, int row, int fq, float invn) {
    float s = ssP[(size_t)row * 4 + fq]; s += __shfl_xor(s, 16); s += __shfl_xor(s, 32); return 1.0f / sqrtf(s * invn + RMS_EPS);
}
__device__ __forceinline__ float sq8(const f32x4 a, const f32x4 b) { return ((a[0] * a[0] + a[1] * a[1]) + (a[2] * a[2] + a[3] * a[3])) + ((b[0] * b[0] + b[1] * b[1]) + (b[2] * b[2] + b[3] * b[3])); }

template <int ACT> struct EpiNormBf16 {
    static constexpr bool PERM = true, AFTER_DRAIN = false;
    bf16_t* O; int ldc; const float* ssP; unsigned qmask; float qscale;
    __device__ __forceinline__ void operator()(const f32x4 (&acc)[2][2][4][2], const Unit& u, int wr, int wc, int fr, int fq) const {
        const int row0 = u.pm * BM + wr * 64 + fr, col0 = u.pn * BM + wc * 32 + 8 * fq;
        const float ts = ((qmask >> u.pn) & 1u) ? qscale : 1.f;
#pragma unroll
        for (int ai = 0; ai < 2; ++ai)
#pragma unroll
            for (int m = 0; m < 4; ++m) { const int row = row0 + ai * HALF + m * 16; const float rs = row_rstd16(ssP, row, fq, 1.0f / 1024.0f) * ts;
                bf16_t* rowp = O + (size_t)row * ldc + col0;
#pragma unroll
                for (int bj = 0; bj < 2; ++bj) { f32x4 v0 = acc[ai][bj][m][0] * rs, v1 = acc[ai][bj][m][1] * rs;
                    if (ACT == 1) {
#pragma unroll
                        for (int e = 0; e < 4; ++e) { const float a = fmaxf(v0[e], 0.f), b = fmaxf(v1[e], 0.f); v0[e] = a * a; v1[e] = b * b; } }
                    *(u32x4*)(rowp + bj * HALF) = pack8(v0, v1); } }
    }
};
struct EpiResid {
    static constexpr bool PERM = true, AFTER_DRAIN = false;
    const bf16_t* xb; bf16_t* xout; float* ssOut;
    __device__ __forceinline__ void operator()(const f32x4 (&acc)[2][2][4][2], const Unit& u, int wr, int wc, int fr, int fq) const {
        const int row0 = u.pm * BM + wr * 64 + fr, col0 = u.pn * BM + wc * 32 + 8 * fq;
#pragma unroll
        for (int ai = 0; ai < 2; ++ai)
#pragma unroll
            for (int m = 0; m < 4; ++m) { const int row = row0 + ai * HALF + m * 16; const size_t off = (size_t)row * 1024 + col0; float s = 0.f;
#pragma unroll
                for (int bj = 0; bj < 2; ++bj) { const u32x4 r = *(const u32x4*)(xb + off + bj * HALF);
                    const f32x4 r0 = {__uint_as_float(r.x << 16), __uint_as_float(r.x & 0xFFFF0000u), __uint_as_float(r.y << 16), __uint_as_float(r.y & 0xFFFF0000u)};
                    const f32x4 r1 = {__uint_as_float(r.z << 16), __uint_as_float(r.z & 0xFFFF0000u), __uint_as_float(r.w << 16), __uint_as_float(r.w & 0xFFFF0000u)};
                    const f32x4 v0 = acc[ai][bj][m][0] + r0, v1 = acc[ai][bj][m][1] + r1;
                    *(u32x4*)(xout + off + bj * HALF) = pack8(v0, v1);
                    s += sq8(v0, v1); }
                s += __shfl_xor(s, 16); s += __shfl_xor(s, 32);
                if (fq == 0) ssOut[(size_t)row * 16 + u.pn * 4 + wc] = s; }
    }
};
struct EpiInOdd {
    static constexpr bool PERM = true, AFTER_DRAIN = false;
    bf16_t* PO; const float* ssP; float qscale; float* ssq; float* sskv; bf16_t* Kd; float* WI; const float* rope;
    __device__ __forceinline__ void operator()(const f32x4 (&acc)[2][2][4][2], const Unit& u, int wr, int wc, int fr, int fq) const {
        const int row0 = u.pm * BM + wr * 64 + fr, col0 = u.pn * BM + wc * 32 + 8 * fq;
        const float ts = (u.pn < 2) ? qscale : 1.f;
#pragma unroll
        for (int ai = 0; ai < 2; ++ai)
#pragma unroll
            for (int m = 0; m < 4; ++m) { const int row = row0 + ai * HALF + m * 16; const float rs = row_rstd16(ssP, row, fq, 1.0f / 1024.0f) * ts;
                bf16_t* rowp = PO + (size_t)row * 1536 + col0;
                const f32x4 a0 = acc[ai][0][m][0] * rs, a1 = acc[ai][0][m][1] * rs, b0 = acc[ai][1][m][0] * rs, b1 = acc[ai][1][m][1] * rs;
                *(u32x4*)(rowp) = pack8(a0, a1); *(u32x4*)(rowp + HALF) = pack8(b0, b1);
                if (u.pn == 2) { float s = sq8(a0, a1) + sq8(b0, b1); s += __shfl_xor(s, 16); s += __shfl_xor(s, 32); if (fq == 0) ssq[(size_t)row * 4 + wc] = s; }
                if (u.pn == 4) { float s = sq8(a0, a1); s += __shfl_xor(s, 16); s += __shfl_xor(s, 32); if (fq == 0) sskv[(size_t)row * 4 + wc] = s; }
                if (u.pn == 5) {
                    if (wc == 1) {
                        const int pos = row & 2047, i0 = 8 * (fq & 1); const float* rp = rope + ((size_t)pos * 16 + i0) * 2;
                        f32x4 o0, o1;
#pragma unroll
                        for (int e = 0; e < 8; ++e) { const float v = e < 4 ? a0[e] : a1[e - 4]; const float w = __shfl_xor(v, 32); const float c = rp[2 * e], sn = rp[2 * e + 1];
                            const float o = (fq < 2) ? (v * c - w * sn) : (w * sn + v * c); if (e < 4) o0[e] = o; else o1[e - 4] = o; }
                        const u32x4 pk = pack8(o0, o1);
#pragma unroll
                        for (int h = 0; h < 8; ++h) *(u32x4*)(Kd + (size_t)row * 768 + h * 96 + 64 + 8 * fq) = pk;
                    }
                    if (wc == 2 && fq == 0) { *(f32x4*)(WI + (size_t)row * 8) = a0; *(f32x4*)(WI + (size_t)row * 8 + 4) = a1; }
                } }
    }
};
struct EpiUq {
    static constexpr bool PERM = true, AFTER_DRAIN = false;
    bf16_t* Qd; const float* ssq; float qscale; const float* rope;
    __device__ __forceinline__ void operator()(const f32x4 (&acc)[2][2][4][2], const Unit& u, int wr, int wc, int fr, int fq) const {
        const int row0 = u.pm * BM + wr * 64 + fr, col0 = u.pn * BM + wc * 32 + 8 * fq;
#pragma unroll
        for (int ai = 0; ai < 2; ++ai)
#pragma unroll
            for (int m = 0; m < 4; ++m) { const int row = row0 + ai * HALF + m * 16; const float rs = row_rstd4(ssq, row, fq, 1.0f / 256.0f) * qscale;
                bf16_t* rowp = Qd + (size_t)row * 768 + col0; const int pos = row & 2047; const float* rp = rope + ((size_t)pos * 16 + 8 * (fq & 1)) * 2;
#pragma unroll
                for (int bj = 0; bj < 2; ++bj) { f32x4 v0 = acc[ai][bj][m][0] * rs, v1 = acc[ai][bj][m][1] * rs;
                    const int g = u.pn * 8 + bj * 4 + wc;
                    if (g % 3 == 2) { f32x4 o0, o1;
#pragma unroll
                        for (int e = 0; e < 8; ++e) { const float v = e < 4 ? v0[e] : v1[e - 4]; const float w = __shfl_xor(v, 32); const float c = rp[2 * e], sn = rp[2 * e + 1];
                            const float o = (fq < 2) ? (v * c - w * sn) : (w * sn + v * c); if (e < 4) o0[e] = o; else o1[e - 4] = o; }
                        v0 = o0; v1 = o1; }
                    *(u32x4*)(rowp + bj * HALF) = pack8(v0, v1); } }
    }
};
struct EpiUkv {
    static constexpr bool PERM = true, AFTER_DRAIN = false;
    bf16_t* Kd; bf16_t* Vd; const float* sskv;
    __device__ __forceinline__ void operator()(const f32x4 (&acc)[2][2][4][2], const Unit& u, int wr, int wc, int fr, int fq) const {
        const int row0 = u.pm * BM + wr * 64 + fr;
#pragma unroll
        for (int ai = 0; ai < 2; ++ai)
#pragma unroll
            for (int m = 0; m < 4; ++m) { const int row = row0 + ai * HALF + m * 16; const float rs = row_rstd4(sskv, row, fq, 1.0f / 128.0f);
#pragma unroll
                for (int bj = 0; bj < 2; ++bj) { const f32x4 v0 = acc[ai][bj][m][0] * rs, v1 = acc[ai][bj][m][1] * rs; const int h = u.pn * 2 + bj, j = wc * 32 + 8 * fq;
                    bf16_t* dst = (wc < 2) ? (Kd + (size_t)row * 768 + h * 96 + j) : (Vd + (size_t)row * 512 + h * 64 + (j - 64));
                    *(u32x4*)dst = pack8(v0, v1); } }
    }
};

template <class Epi, class Sched, bool ALIGN_EPI = false, bool SP2 = false>
__device__ __forceinline__ void gemm_phase(PG8_LAS unsigned char* lds, const Gemm g, const Sched& S, const Epi& E) {
    const int tid = threadIdx.x, wid = __builtin_amdgcn_readfirstlane(tid >> 6), lane = tid & 63, wr = wid >> 2, wc = wid & 3, fr = lane & 15, fq = lane >> 4;
    const int K = g.K, nt = K / BK;
    unsigned voffA[2], voffB[2];
#pragma unroll
    for (int i = 0; i < 2; ++i) { int R, C; stage_rc(tid * 16 + i * 8192, R, C); const int Rb = Epi::PERM ? ((R & ~31) + perm32(R & 31)) : R;
        voffA[i] = (unsigned)(R * g.lda + C) * 2u; voffB[i] = (unsigned)(Rb * K + C) * 2u; }
    const size_t kstep = (size_t)(BK * 2);
    const size_t hstep = (size_t)HALF * K * 2;
    const size_t tstep = 2 * hstep; const size_t hstepA = (size_t)HALF * g.lda * 2, tstepA = 2 * hstepA;
    const unsigned ldsw = (unsigned)wid * 1024u;
    const int aoff = lds_byte(wr * 64 + fr, fq * 8), boff = lds_byte(wc * 32 + fr, fq * 8);
#define PG8_SA(b, h) (((b) * 2 + (h)) * HTB)
#define PG8_SB(b, h) ((4 + (b) * 2 + (h)) * HTB)
#define PG8_STAGE(bufoff, gbase, voff) do { _Pragma("unroll") for (int _i = 0; _i < 2; ++_i) \
        __builtin_amdgcn_global_load_lds((const unsigned*)((const char*)(gbase) + (voff)[_i]), (PG8_LAS unsigned*)(lds + (bufoff) + ldsw + _i * 8192), 16, 0, 0); } while (0)
#define PG8_LDA(dst, b, h) do { _Pragma("unroll") for (int m = 0; m < 4; ++m) _Pragma("unroll") for (int k = 0; k < 2; ++k) dst[m][k] = *(const PG8_LAS bf16x8*)(lds + PG8_SA(b, h) + aoff + m * 2048 + k * 1024); } while (0)
#define PG8_LDB(dst, b, h) do { _Pragma("unroll") for (int n = 0; n < 2; ++n) _Pragma("unroll") for (int k = 0; k < 2; ++k) dst[n][k] = *(const PG8_LAS bf16x8*)(lds + PG8_SB(b, h) + boff + n * 2048 + k * 1024); } while (0)
#define PG8_MMA(ai, bj, At, Bt) do { __builtin_amdgcn_s_setprio(1); _Pragma("unroll") for (int m = 0; m < 4; ++m) _Pragma("unroll") for (int n = 0; n < 2; ++n) _Pragma("unroll") for (int k = 0; k < 2; ++k) \
        acc[ai][bj][m][n] = __builtin_amdgcn_mfma_f32_16x16x32_bf16(Bt[n][k], At[m][k], acc[ai][bj][m][n], 0, 0, 0); __builtin_amdgcn_s_setprio(0); } while (0)
#define PG8_WAIT_V(n) asm volatile("s_waitcnt vmcnt(" #n ")" ::: "memory")
#define PG8_WAIT_L(n) asm volatile("s_waitcnt lgkmcnt(" #n ")" ::: "memory")
#define PG8_BAR __builtin_amdgcn_s_barrier()
#define PG8_SCHED __builtin_amdgcn_sched_barrier(0)
    Unit cur, nxt; int ui = 0;
    if (!S.next(0, cur)) return;
    f32x4 acc[2][2][4][2];
#pragma unroll
    for (int a = 0; a < 2; ++a)
#pragma unroll
        for (int b = 0; b < 2; ++b)
#pragma unroll
            for (int m = 0; m < 4; ++m)
#pragma unroll
                for (int n = 0; n < 2; ++n) acc[a][b][m][n] = (f32x4){0.f, 0.f, 0.f, 0.f};
    bf16x8 At[4][2], B0[2][2], B1[2][2];
    const char* cA = (const char*)g.A + (size_t)cur.pm * tstepA; const char* cB = (const char*)g.Bt + (size_t)cur.pn * tstep;
    S.a_ready(cur);
    if constexpr (SP2) {
        PG8_STAGE(PG8_SB(0, 0), cB, voffB); PG8_STAGE(PG8_SB(0, 1), cB + hstep, voffB); PG8_STAGE(PG8_SA(0, 0), cA, voffA); PG8_STAGE(PG8_SA(0, 1), cA + hstepA, voffA);
        if (wr == 1) PG8_BAR;
        PG8_WAIT_V(2); PG8_BAR;
        PG8_STAGE(PG8_SB(1, 0), cB + kstep, voffB); PG8_STAGE(PG8_SA(1, 0), cA + kstep, voffA); PG8_STAGE(PG8_SB(1, 1), cB + hstep + kstep, voffB);
        PG8_WAIT_V(6); PG8_BAR;
    } else {
        PG8_STAGE(PG8_SB(0, 0), cB, voffB); PG8_STAGE(PG8_SA(0, 0), cA, voffA); PG8_STAGE(PG8_SB(0, 1), cB + hstep, voffB); PG8_STAGE(PG8_SA(0, 1), cA + hstepA, voffA);
        if (wr == 1) PG8_BAR;
        PG8_WAIT_V(4); PG8_BAR;
        PG8_STAGE(PG8_SB(1, 0), cB + kstep, voffB); PG8_STAGE(PG8_SA(1, 0), cA + kstep, voffA); PG8_STAGE(PG8_SB(1, 1), cB + hstep + kstep, voffB);
        PG8_WAIT_V(6); PG8_BAR;
    }
    for (;;) {
        const bool has_next = S.next(ui + 1, nxt);
        const char* nA = has_next ? (const char*)g.A + (size_t)nxt.pm * tstepA : cA; const char* nB = has_next ? (const char*)g.Bt + (size_t)nxt.pn * tstep : cB;
        for (int t = 0; t < nt; t += 2) {
            const bool last = (t == nt - 2);
            const char* a1 = cA + (size_t)(t + 1) * kstep;
            const char* a2 = last ? nA : cA + (size_t)(t + 2) * kstep; const char* b2 = last ? nB : cB + (size_t)(t + 2) * kstep;
            const char* a3 = a2 + kstep; const char* b3 = b2 + kstep;
            if (last && has_next) S.a_ready(nxt);
            if constexpr (SP2) {
            PG8_LDB(B0, 0, 0); PG8_LDB(B1, 0, 1); PG8_SCHED; PG8_LDA(At, 0, 0); PG8_STAGE(PG8_SA(1, 1), a1 + hstepA, voffA);
            PG8_WAIT_V(8); PG8_WAIT_L(0); PG8_BAR; PG8_MMA(0, 0, At, B0); PG8_MMA(0, 1, At, B1); PG8_BAR; PG8_SCHED;
            PG8_LDA(At, 0, 1); PG8_STAGE(PG8_SB(0, 0), b2, voffB); PG8_STAGE(PG8_SB(0, 1), b2 + hstep, voffB); PG8_STAGE(PG8_SA(0, 0), a2, voffA);
            PG8_WAIT_V(8); PG8_WAIT_L(0); PG8_BAR; PG8_MMA(1, 0, At, B0); PG8_MMA(1, 1, At, B1); PG8_BAR; PG8_SCHED;
            PG8_LDB(B0, 1, 0); PG8_LDB(B1, 1, 1); PG8_SCHED; PG8_LDA(At, 1, 0); PG8_STAGE(PG8_SA(0, 1), a2 + hstepA, voffA);
            PG8_WAIT_V(8); PG8_WAIT_L(0); PG8_BAR; PG8_MMA(0, 0, At, B0); PG8_MMA(0, 1, At, B1); PG8_BAR; PG8_SCHED;
            PG8_LDA(At, 1, 1); PG8_STAGE(PG8_SB(1, 0), b3, voffB); PG8_STAGE(PG8_SB(1, 1), b3 + hstep, voffB); PG8_STAGE(PG8_SA(1, 0), a3, voffA);
            PG8_WAIT_V(8); PG8_WAIT_L(0); PG8_BAR; PG8_MMA(1, 0, At, B0); PG8_MMA(1, 1, At, B1); PG8_BAR; PG8_SCHED;
            } else {
            PG8_LDB(B0, 0, 0); PG8_SCHED; PG8_LDA(At, 0, 0); PG8_STAGE(PG8_SA(1, 1), a1 + hstepA, voffA);
            PG8_WAIT_L(8); PG8_BAR; PG8_WAIT_L(0); PG8_MMA(0, 0, At, B0); PG8_BAR; PG8_SCHED;
            PG8_LDB(B1, 0, 1); PG8_STAGE(PG8_SB(0, 0), b2, voffB);
            PG8_BAR; PG8_WAIT_L(0); PG8_MMA(0, 1, At, B1); PG8_BAR;
            PG8_LDA(At, 0, 1); PG8_STAGE(PG8_SA(0, 0), a2, voffA);
            PG8_BAR; PG8_WAIT_L(0); PG8_MMA(1, 0, At, B0); PG8_BAR; PG8_SCHED;
            PG8_STAGE(PG8_SB(0, 1), b2 + hstep, voffB);
            PG8_WAIT_V(6); PG8_BAR; PG8_MMA(1, 1, At, B1); PG8_BAR;
            PG8_LDB(B0, 1, 0); PG8_SCHED; PG8_LDA(At, 1, 0); PG8_STAGE(PG8_SA(0, 1), a2 + hstepA, voffA);
            PG8_WAIT_L(8); PG8_BAR; PG8_WAIT_L(0); PG8_MMA(0, 0, At, B0); PG8_BAR; PG8_SCHED;
            PG8_LDB(B1, 1, 1); PG8_STAGE(PG8_SB(1, 0), b3, voffB);
            PG8_BAR; PG8_WAIT_L(0); PG8_MMA(0, 1, At, B1); PG8_BAR;
            PG8_LDA(At, 1, 1); PG8_STAGE(PG8_SA(1, 0), a3, voffA);
            PG8_BAR; PG8_WAIT_L(0); PG8_MMA(1, 0, At, B0); PG8_BAR; PG8_SCHED;
            PG8_STAGE(PG8_SB(1, 1), b3 + hstep, voffB);
            PG8_WAIT_V(6); PG8_BAR; PG8_MMA(1, 1, At, B1); PG8_BAR;
            }
        }
        if constexpr (ALIGN_EPI) { if (wr == 0) PG8_BAR; }
        if constexpr (!Epi::AFTER_DRAIN) { E(acc, cur, wr, wc, fr, fq); S.done(cur); }
        if (!has_next) break;
#pragma unroll
        for (int a = 0; a < 2; ++a)
#pragma unroll
            for (int b = 0; b < 2; ++b)
#pragma unroll
                for (int m = 0; m < 4; ++m)
#pragma unroll
                    for (int n = 0; n < 2; ++n) acc[a][b][m][n] = (f32x4){0.f, 0.f, 0.f, 0.f};
        cur = nxt; cA = nA; cB = nB; ++ui;
        if constexpr (ALIGN_EPI) { if (wr == 1) PG8_BAR; }
    }
    PG8_WAIT_V(0);
    if constexpr (!ALIGN_EPI) { if (wr == 0) PG8_BAR; }
    PG8_BAR;
    if constexpr (Epi::AFTER_DRAIN) { E.fused(acc, cur, wr, wc, fr, fq, lds, wid, lane); S.done(cur); }
#undef PG8_SA
#undef PG8_SB
#undef PG8_STAGE
#undef PG8_LDA
#undef PG8_LDB
#undef PG8_MMA
#undef PG8_WAIT_V
#undef PG8_WAIT_L
#undef PG8_BAR
#undef PG8_SCHED
}
}

namespace att {
#define ALAS __attribute__((address_space(3)))
typedef unsigned short bf16_t;
typedef short bf16x8 __attribute__((ext_vector_type(8)));
typedef short s16x4 __attribute__((ext_vector_type(4)));
typedef float f32x4 __attribute__((ext_vector_type(4)));
typedef float f32x16 __attribute__((ext_vector_type(16)));
typedef unsigned u32x4 __attribute__((ext_vector_type(4)));
typedef unsigned u32x2 __attribute__((ext_vector_type(2)));
typedef float f32x2_t __attribute__((ext_vector_type(2))); typedef __bf16 bf16x2_t __attribute__((ext_vector_type(2)));
constexpr float LOG2E = 1.4426950408889634f;
constexpr int BIAS_LDS_OFF = 65536;
__device__ __forceinline__ unsigned cvtpk(float lo, float hi) { f32x2_t v = {lo, hi}; bf16x2_t b = __builtin_convertvector(v, bf16x2_t); return __builtin_bit_cast(unsigned, b); }
__device__ __forceinline__ s16x4 vtr(const ALAS unsigned char* p) { typedef short v4i16_t __attribute__((ext_vector_type(4))); return __builtin_bit_cast(s16x4, __builtin_amdgcn_ds_read_tr16_b64_v4i16((ALAS v4i16_t*)p)); }
__device__ __forceinline__ int crow(int i, int hi) { return (i & 3) + 8 * (i >> 2) + 4 * hi; }

struct AU {
    const bf16_t* Q; int ldq;
    const bf16_t* K; int ldk;
    const bf16_t* V; int ldv;
    bf16_t* O; int ldo;
    int tok0;
    int qpos;
    int t_lo, t_hi;
    const float* F2; float cb;
    const ALAS float* bias;
    float sink2;
    const unsigned long long* bm;
};

constexpr float THR = 8.0f;
__device__ __forceinline__ float hmax(float v) { auto rr = __builtin_amdgcn_permlane32_swap(__float_as_uint(v), __float_as_uint(v), false, false); return fmaxf(__uint_as_float(rr[0]), __uint_as_float(rr[1])); }
__device__ __forceinline__ float hsum(float v) { auto rr = __builtin_amdgcn_permlane32_swap(__float_as_uint(v), __float_as_uint(v), false, false); return __uint_as_float(rr[0]) + __uint_as_float(rr[1]); }
struct SMState { float m, l; f32x16 o0, o1, negm; bool first; };
template <int DK, int MODE>
__device__ __forceinline__ void tile_compute(const AU& u, const ALAS unsigned char* Kb, int t, SMState& st, const bf16x8 (&qr)[DK / 16], unsigned koff, unsigned vbase, int q, int hi) {
    constexpr int KSTR = DK * 2 + 16, KB = 64 * KSTR, VB = 8192, NKS = DK / 16;
    const int kt0 = t * 64;
    unsigned long long mw = 0ull;
    if (MODE == 2) mw = u.bm[(size_t)q * 32 + t];
    bf16x8 kf[2 * NKS];
#pragma unroll
    for (int ks = 0; ks < NKS; ++ks) { kf[2 * ks] = *(const ALAS bf16x8*)(Kb + koff + ks * 32); kf[2 * ks + 1] = *(const ALAS bf16x8*)(Kb + koff + 32 * KSTR + ks * 32); }
    f32x16 p0, p1;
    if (MODE == 0) { const ALAS float* fk = (const ALAS float*)(Kb + KB + VB);
#pragma unroll
        for (int g = 0; g < 4; ++g) { const f32x4 a = *(const ALAS f32x4*)(fk + 8 * g + 4 * hi), b = *(const ALAS f32x4*)(fk + 32 + 8 * g + 4 * hi);
#pragma unroll
            for (int e = 0; e < 4; ++e) { p0[4 * g + e] = a[e] - st.m; p1[4 * g + e] = b[e] - st.m; } } }
    else { p0 = st.negm; p1 = st.negm; }
    __builtin_amdgcn_sched_barrier(0);
#pragma unroll
    for (int ks = 0; ks < NKS; ++ks) {
        p0 = __builtin_amdgcn_mfma_f32_32x32x16_bf16(kf[2 * ks], qr[ks], p0, 0, 0, 0);
        p1 = __builtin_amdgcn_mfma_f32_32x32x16_bf16(kf[2 * ks + 1], qr[ks], p1, 0, 0, 0);
    }
    const ALAS unsigned char* vp = Kb + vbase;
    s16x4 va[4][4];
#pragma unroll
    for (int s = 0; s < 4; ++s) { va[s][0] = vtr(vp + s * 2048); va[s][1] = vtr(vp + s * 2048 + 1024); va[s][2] = vtr(vp + s * 2048 + 256); va[s][3] = vtr(vp + s * 2048 + 1024 + 256); }
    __builtin_amdgcn_sched_barrier(0);
    if (MODE == 0 || MODE == 3) {
        if (kt0 + 63 > u.qpos) {
#pragma unroll
            for (int i = 0; i < 16; ++i) { const int key = kt0 + crow(i, hi); if (key > q) p0[i] = -INFINITY; if (key + 32 > q) p1[i] = -INFINITY; } }
    } else if (MODE == 1 || kt0 + 63 + 127 >= u.qpos) {
        const int db = q - kt0 - 4 * hi;
#pragma unroll
        for (int i = 0; i < 16; ++i) { const int d0 = db - ((i & 3) + 8 * (i >> 2)), d1 = d0 - 32;
            const int i0 = d0 < 0 ? 0 : (d0 > 127 ? 127 : d0), i1 = d1 < 0 ? 0 : (d1 > 127 ? 127 : d1);
            p0[i] += u.bias[i0]; p1[i] += u.bias[i1]; }
    }
    float rm = fmaxf(fmaxf(p0[0], p0[1]), p1[0]), rb = fmaxf(fmaxf(p0[2], p0[3]), p1[1]); rm = fmaxf(fmaxf(rm, p1[2]), p1[3]);
#pragma unroll
    for (int i = 4; i < 16; i += 4) { rm = fmaxf(fmaxf(rm, p0[i]), p0[i + 1]); rb = fmaxf(fmaxf(rb, p0[i + 2]), p0[i + 3]); rm = fmaxf(fmaxf(rm, p1[i]), p1[i + 1]); rb = fmaxf(fmaxf(rb, p1[i + 2]), p1[i + 3]); }
    rm = hmax(fmaxf(rm, rb));
    if (st.first || __any(rm > THR)) {
        const float dl = st.first ? rm : (rm > THR ? rm : 0.f); st.m += dl;
#pragma unroll
        for (int i = 0; i < 16; ++i) { p0[i] -= dl; p1[i] -= dl; st.negm[i] = -st.m; }
        if (!st.first) { const float f = __builtin_amdgcn_exp2f(-dl); st.l *= f;
#pragma unroll
            for (int i = 0; i < 16; ++i) { st.o0[i] *= f; st.o1[i] *= f; } }
        st.first = false;
    }
#pragma unroll
    for (int i = 0; i < 16; ++i) { p0[i] = __builtin_amdgcn_exp2f(p0[i]); p1[i] = __builtin_amdgcn_exp2f(p1[i]); }
    if (MODE == 1) { const int db = q - kt0 - 4 * hi;
#pragma unroll
        for (int i = 0; i < 16; ++i) { const int d0 = db - ((i & 3) + 8 * (i >> 2)), d1 = d0 - 32; p0[i] = ((unsigned)d0 < 128u) ? p0[i] : 0.f; p1[i] = ((unsigned)d1 < 128u) ? p1[i] : 0.f; } }
    if (MODE == 2) { const int lo = (int)((unsigned)mw >> (4 * hi)), hw = (int)((unsigned)(mw >> 32) >> (4 * hi));
#pragma unroll
        for (int i = 0; i < 16; ++i) { const int bit = (i & 3) + 8 * (i >> 2);
            p0[i] = __uint_as_float(__float_as_uint(p0[i]) & (unsigned)__builtin_amdgcn_sbfe(lo, bit, 1)); p1[i] = __uint_as_float(__float_as_uint(p1[i]) & (unsigned)__builtin_amdgcn_sbfe(hw, bit, 1)); } }
    float rs0 = 0.f, rs1 = 0.f;
#pragma unroll
    for (int i = 0; i < 16; ++i) { rs0 += p0[i]; rs1 += p1[i]; }
    st.l += rs0 + rs1;
    u32x4 pw[4];
#pragma unroll
    for (int s = 0; s < 2; ++s) { pw[s] = (u32x4){cvtpk(p0[8 * s], p0[8 * s + 1]), cvtpk(p0[8 * s + 2], p0[8 * s + 3]), cvtpk(p0[8 * s + 4], p0[8 * s + 5]), cvtpk(p0[8 * s + 6], p0[8 * s + 7])};
        pw[2 + s] = (u32x4){cvtpk(p1[8 * s], p1[8 * s + 1]), cvtpk(p1[8 * s + 2], p1[8 * s + 3]), cvtpk(p1[8 * s + 4], p1[8 * s + 5]), cvtpk(p1[8 * s + 6], p1[8 * s + 7])}; }
#pragma unroll
    for (int s = 0; s < 4; ++s) {
        const bf16x8 vf0 = (bf16x8){va[s][0][0], va[s][0][1], va[s][0][2], va[s][0][3], va[s][1][0], va[s][1][1], va[s][1][2], va[s][1][3]};
        const bf16x8 vf1 = (bf16x8){va[s][2][0], va[s][2][1], va[s][2][2], va[s][2][3], va[s][3][0], va[s][3][1], va[s][3][2], va[s][3][3]};
        const bf16x8 pf = __builtin_bit_cast(bf16x8, pw[s]);
        st.o0 = __builtin_amdgcn_mfma_f32_32x32x16_bf16(vf0, pf, st.o0, 0, 0, 0);
        st.o1 = __builtin_amdgcn_mfma_f32_32x32x16_bf16(vf1, pf, st.o1, 0, 0, 0);
    }
}
struct NoHook { __device__ __forceinline__ void operator()() const {} };
template <int DK, int MODE, class Hook = NoHook>
__device__ __forceinline__ void attn_unit(const AU& u, ALAS unsigned char* lds, const Hook& hook = Hook()) {
    constexpr int KSTR = DK * 2 + 16, KB = 64 * KSTR, VB = 8192, BUF = KB + VB + 256, NKS = DK / 16, CPR = DK / 8;
    static_assert(3 * BUF <= BIAS_LDS_OFF, "attention ring vs bias tables");
    const int tid = threadIdx.x, lane = tid & 63, r32 = lane & 31, hi = lane >> 5;
    const int q = u.qpos + r32;
    bf16x8 qr[NKS];
    { const bf16_t* qp = u.Q + (size_t)(u.tok0 + q) * u.ldq + hi * 8;
#pragma unroll
      for (int ks = 0; ks < NKS; ++ks) qr[ks] = *(const bf16x8*)(qp + ks * 16); }
    const int kr0 = tid / CPR, kc0 = tid % CPR, kr1 = (tid + 512) / CPR, kc1 = (tid + 512) % CPR;
    const int vr = tid >> 3, vc = tid & 7;
    const unsigned kdst0 = kr0 * KSTR + kc0 * 16, kdst1 = kr1 * KSTR + kc1 * 16;
    const unsigned vdst = KB + ((vr >> 2) * 2 + (vc >> 2)) * 256 + (vr & 3) * 64 + (vc & 3) * 16;
    const bf16_t* kg0 = u.K + (size_t)(u.tok0 + kr0) * u.ldk + kc0 * 8;
    const bf16_t* kg1 = u.K + (size_t)(u.tok0 + kr1) * u.ldk + kc1 * 8;
    const bf16_t* vg = u.V + (size_t)(u.tok0 + vr) * u.ldv + vc * 8;
    const bool k2 = (DK == 96) && (tid < 256);
    u32x4 kA0, kA1 = {0u, 0u, 0u, 0u}, vA, kB0, kB1 = {0u, 0u, 0u, 0u}, vB; float fA = 0.f, fB = 0.f;
#define AT_LOAD(S, t) do { const size_t ro_ = (size_t)(t) * 64; k##S##0 = *(const u32x4*)(kg0 + ro_ * u.ldk); if (k2) k##S##1 = *(const u32x4*)(kg1 + ro_ * u.ldk); \
        v##S = *(const u32x4*)(vg + ro_ * u.ldv); if (MODE == 0) { if (tid < 64) f##S = u.cb - u.F2[(t) * 64 + tid]; } } while (0)
#define AT_STORE(S, bo) do { ALAS unsigned char* b_ = lds + (bo); *(ALAS u32x4*)(b_ + kdst0) = k##S##0; if (k2) *(ALAS u32x4*)(b_ + kdst1) = k##S##1; \
        *(ALAS u32x4*)(b_ + vdst) = v##S; if (MODE == 0) { if (tid < 64) *(ALAS float*)(b_ + KB + VB + tid * 4) = f##S; } } while (0)
    SMState st; st.m = 0.f; st.l = 0.f; st.o0 = f32x16{}; st.o1 = f32x16{}; st.negm = f32x16{}; st.first = true;
    const unsigned koff = r32 * KSTR + hi * 16;
    const unsigned vbase = KB + hi * 512 + ((lane & 15) >> 2) * 64 + ((lane >> 4) & 1) * 32 + (lane & 3) * 8;
    const int n = u.t_hi - u.t_lo;
    AT_LOAD(A, u.t_lo); AT_STORE(A, 0); if (n > 1) AT_LOAD(B, u.t_lo + 1);
    __syncthreads();
    int bo = 0;
#define AT_BAR() do { asm volatile("s_waitcnt lgkmcnt(0)" ::: "memory"); __builtin_amdgcn_s_barrier(); asm volatile("" ::: "memory"); } while (0)
#define AT_ACTIVE(t) (((t) * 64 <= u.qpos + 31) && (MODE != 1 || (t) * 64 + 63 + 127 >= u.qpos))
    for (int i = 0; i < n; i += 2) {
        { const int t = u.t_lo + i; const int bn = (bo == 2 * BUF) ? 0 : bo + BUF;
          if (i + 2 < n) AT_LOAD(A, t + 2);
          if (AT_ACTIVE(t)) tile_compute<DK, MODE>(u, lds + bo, t, st, qr, koff, vbase, q, hi);
          if (i + 1 < n) AT_STORE(B, bn);
          AT_BAR(); bo = bn; }
        if (i == 0) hook();
        if (i + 1 < n) { const int t = u.t_lo + i + 1; const int bn = (bo == 2 * BUF) ? 0 : bo + BUF;
          if (i + 3 < n) AT_LOAD(B, t + 2);
          if (AT_ACTIVE(t)) tile_compute<DK, MODE>(u, lds + bo, t, st, qr, koff, vbase, q, hi);
          if (i + 2 < n) AT_STORE(A, bn);
          AT_BAR(); bo = bn; }
    }
#undef AT_LOAD
#undef AT_STORE
#undef AT_ACTIVE
#undef AT_BAR
    float l = hsum(st.l);
    if (MODE == 1) l += __builtin_amdgcn_exp2f(u.sink2 - st.m);
    const float inv = 1.0f / l;
    bf16_t* op = u.O + (size_t)(u.tok0 + q) * u.ldo + 4 * hi;
#pragma unroll
    for (int g = 0; g < 4; ++g) {
        u32x2 w0 = {cvtpk(st.o0[4 * g] * inv, st.o0[4 * g + 1] * inv), cvtpk(st.o0[4 * g + 2] * inv, st.o0[4 * g + 3] * inv)};
        u32x2 w1 = {cvtpk(st.o1[4 * g] * inv, st.o1[4 * g + 1] * inv), cvtpk(st.o1[4 * g + 2] * inv, st.o1[4 * g + 3] * inv)};
        *(u32x2*)(op + 8 * g) = w0; *(u32x2*)(op + 32 + 8 * g) = w1;
    }
}

constexpr int SROW = 2052;
__device__ __forceinline__ unsigned wave_sum_u32(unsigned v) {
    v += (unsigned)__builtin_amdgcn_update_dpp(0, (int)v, 0xB1, 0xF, 0xF, true);
    v += (unsigned)__builtin_amdgcn_update_dpp(0, (int)v, 0x4E, 0xF, 0xF, true);
    v += (unsigned)__builtin_amdgcn_update_dpp(0, (int)v, 0x141, 0xF, 0xF, true);
    v += (unsigned)__builtin_amdgcn_update_dpp(0, (int)v, 0x140, 0xF, 0xF, true);
    return (unsigned)__builtin_amdgcn_readlane((int)v, 0) + (unsigned)__builtin_amdgcn_readlane((int)v, 16) + (unsigned)__builtin_amdgcn_readlane((int)v, 32) + (unsigned)__builtin_amdgcn_readlane((int)v, 48);
}
__device__ __forceinline__ unsigned wave_min_u32(unsigned v) {
    v = min(v, (unsigned)__builtin_amdgcn_update_dpp(-1, (int)v, 0xB1, 0xF, 0xF, false));
    v = min(v, (unsigned)__builtin_amdgcn_update_dpp(-1, (int)v, 0x4E, 0xF, 0xF, false));
    v = min(v, (unsigned)__builtin_amdgcn_update_dpp(-1, (int)v, 0x141, 0xF, 0xF, false));
    v = min(v, (unsigned)__builtin_amdgcn_update_dpp(-1, (int)v, 0x140, 0xF, 0xF, false));
    return min(min((unsigned)__builtin_amdgcn_readlane((int)v, 0), (unsigned)__builtin_amdgcn_readlane((int)v, 16)), min((unsigned)__builtin_amdgcn_readlane((int)v, 32), (unsigned)__builtin_amdgcn_readlane((int)v, 48)));
}
__device__ __forceinline__ unsigned wave_max_u32(unsigned v) {
    v = max(v, (unsigned)__builtin_amdgcn_update_dpp(0, (int)v, 0xB1, 0xF, 0xF, false));
    v = max(v, (unsigned)__builtin_amdgcn_update_dpp(0, (int)v, 0x4E, 0xF, 0xF, false));
    v = max(v, (unsigned)__builtin_amdgcn_update_dpp(0, (int)v, 0x141, 0xF, 0xF, false));
    v = max(v, (unsigned)__builtin_amdgcn_update_dpp(0, (int)v, 0x140, 0xF, 0xF, false));
    return max(max((unsigned)__builtin_amdgcn_readlane((int)v, 0), (unsigned)__builtin_amdgcn_readlane((int)v, 16)), max((unsigned)__builtin_amdgcn_readlane((int)v, 32), (unsigned)__builtin_amdgcn_readlane((int)v, 48)));
}
__device__ __forceinline__ float unsortable(unsigned k) { return __uint_as_float((k & 0x80000000u) ? (k & 0x7FFFFFFFu) : ~k); }
template <int LN> __device__ __forceinline__ void wlane(unsigned& dst, unsigned val) { asm volatile("s_nop 1\n\tv_writelane_b32 %0, %1, %2" : "+v"(dst) : "s"(val), "i"(LN)); }
template <int I, int NREG> __device__ __forceinline__ void fin_fast(const unsigned (&ua)[NREG], const unsigned (&ub)[NREG], unsigned Ta, unsigned Tb, unsigned& alo, unsigned& ahi, unsigned& blo, unsigned& bhi) {
    if constexpr (I < NREG) { const unsigned long long wa = __ballot(ua[I] >= Ta), wb = __ballot(ub[I] >= Tb);
        wlane<I>(alo, (unsigned)wa); wlane<I>(ahi, (unsigned)(wa >> 32)); wlane<I>(blo, (unsigned)wb); wlane<I>(bhi, (unsigned)(wb >> 32));
        fin_fast<I + 1, NREG>(ua, ub, Ta, Tb, alo, ahi, blo, bhi); }
}
__device__ __forceinline__ unsigned sortable(float f) { const unsigned b = __float_as_uint(f); return (b & 0x80000000u) ? ~b : (b | 0x80000000u); }
__device__ __forceinline__ unsigned bracket_mid(unsigned lo, unsigned hi, bool integer_only) {
    const unsigned im = lo + ((hi - lo) >> 1);
    if (integer_only) return im;
    const float m = 0.5f * unsortable(lo) + 0.5f * unsortable(hi); const unsigned mk = sortable(m);
    return (mk > lo && mk < hi) ? mk : im;
}
template <int NREG>
__device__ __forceinline__ void select2(const ALAS float* Sa, const ALAS float* Sb, int ta, unsigned long long* bma, unsigned long long* bmb, int lane, int itcap, int nreg, const ALAS unsigned* mm) {
    unsigned ua[NREG], ub[NREG];
#pragma unroll
    for (int i = 0; i < NREG; ++i) { ua[i] = 0u; ub[i] = 0u; if (i < nreg) { const unsigned xa_ = sortable(Sa[64 * i + lane]), xb_ = sortable(Sb[64 * i + lane]); ua[i] = (64 * i + lane <= ta) ? xa_ : 0u; ub[i] = (64 * i + lane <= ta + 1) ? xb_ : 0u; } }
    unsigned Ta = (unsigned)__builtin_amdgcn_readfirstlane((int)mm[0]) + 1u, Tb = (unsigned)__builtin_amdgcn_readfirstlane((int)mm[1]) + 1u, Ha = (unsigned)__builtin_amdgcn_readfirstlane((int)mm[16]) + 1u, Hb = (unsigned)__builtin_amdgcn_readfirstlane((int)mm[17]) + 1u;
    unsigned ca = (unsigned)(ta + 1), cb = (unsigned)(ta + 2); bool da = false, db = false;
#pragma unroll 1
    for (int it = 0; it < itcap; ++it) {
        const unsigned xa = da ? Ta : bracket_mid(Ta, Ha, it >= 28), xb = db ? Tb : bracket_mid(Tb, Hb, it >= 28);
        unsigned na = 0u, nb = 0u;
#pragma unroll
        for (int i = 0; i < NREG; ++i) { na += (unsigned)__builtin_popcountll(__ballot(ua[i] >= xa)); nb += (unsigned)__builtin_popcountll(__ballot(ub[i] >= xb)); }
        if (!da) { if (na >= 256u) { Ta = xa; ca = na; } else Ha = xa; da = (ca == 256u) || (Ha - Ta <= 1u); }
        if (!db) { if (nb >= 256u) { Tb = xb; cb = nb; } else Hb = xb; db = (cb == 256u) || (Hb - Tb <= 1u); }
        if (da && db) break;
    }
    unsigned long long mya = 0ull, myb = 0ull; unsigned mya_lo = 0u, mya_hi = 0u, myb_lo = 0u, myb_hi = 0u;
    if (ca == 256u && cb == 256u) {
        fin_fast<0, NREG>(ua, ub, Ta, Tb, mya_lo, mya_hi, myb_lo, myb_hi);
        mya = ((unsigned long long)mya_hi << 32) | mya_lo; myb = ((unsigned long long)myb_hi << 32) | myb_lo;
    } else {
        unsigned g = 0u;
#pragma unroll
        for (int i = 0; i < NREG; ++i) { g += (ua[i] > Ta) ? 1u : 0u; g += (ub[i] > Tb) ? 0x10000u : 0u; }
        const unsigned gt = wave_sum_u32(g); int needa = 256 - (int)(gt & 0xFFFFu), needb = 256 - (int)(gt >> 16);
#pragma unroll
        for (int i = 0; i < NREG; ++i) {
            const unsigned long long ga = __ballot(ua[i] > Ta), ea = __ballot(ua[i] == Ta), gb = __ballot(ub[i] > Tb), eb = __ballot(ub[i] == Tb);
            const int rka = __builtin_amdgcn_mbcnt_hi((unsigned)(ea >> 32), __builtin_amdgcn_mbcnt_lo((unsigned)ea, 0u)), rkb = __builtin_amdgcn_mbcnt_hi((unsigned)(eb >> 32), __builtin_amdgcn_mbcnt_lo((unsigned)eb, 0u));
            const unsigned long long tka = __ballot((ua[i] == Ta) && (rka < needa)), tkb = __ballot((ub[i] == Tb) && (rkb < needb));
            needa -= __builtin_popcountll(tka); needb -= __builtin_popcountll(tkb);
            if (lane == i) { mya = ga | tka; myb = gb | tkb; } }
    }
    if (lane < 32) { bma[lane] = mya; bmb[lane] = myb; }
}
__device__ __forceinline__ float wave_minf(float v) {
#pragma unroll
    for (int o = 1; o < 64; o <<= 1) v = fminf(v, __shfl_xor(v, o));
    return v;
}
__device__ __forceinline__ float wave_maxf(float v) {
#pragma unroll
    for (int o = 1; o < 64; o <<= 1) v = fmaxf(v, __shfl_xor(v, o));
    return v;
}
template <int NREG>
__device__ __forceinline__ void hist_level(const unsigned (&breg)[NREG], ALAS unsigned* hist, int lane, unsigned& need, unsigned& bstar, unsigned& ncand) {
    *(ALAS u32x4*)(hist + 4 * lane) = (u32x4){0u, 0u, 0u, 0u};
#pragma unroll
    for (int i = 0; i < NREG; ++i) { if (breg[i] - 1u < 256u) __hip_atomic_fetch_add(hist + breg[i] - 1u, 1u, __ATOMIC_RELAXED, __HIP_MEMORY_SCOPE_WORKGROUP); }
    const u32x4 h4 = *(const ALAS u32x4*)(hist + 252 - 4 * lane);
    const unsigned loc = (h4[0] + h4[1]) + (h4[2] + h4[3]); unsigned incl = loc;
#pragma unroll
    for (int o = 1; o < 64; o <<= 1) { const unsigned v = (unsigned)__shfl_up((int)incl, o); if (lane >= o) incl += v; }
    const unsigned excl = incl - loc;
    const unsigned long long crossm = __ballot(excl < need && incl >= need);
    const int cl = __builtin_ctzll(crossm);
    unsigned c = excl, bst = 0u, nc = 0u, above = 0u; bool fnd = false;
#pragma unroll
    for (int k = 3; k >= 0; --k) { if (!fnd) { if (c + h4[k] >= need) { bst = (unsigned)(252 - 4 * lane + k); nc = h4[k]; above = c; fnd = true; } else c += h4[k]; } }
    bstar = (unsigned)__builtin_amdgcn_readlane((int)bst, cl) + 1u; ncand = (unsigned)__builtin_amdgcn_readlane((int)nc, cl); need -= (unsigned)__builtin_amdgcn_readlane((int)above, cl);
}
template <int NREG>
__device__ __forceinline__ bool hist_refine(unsigned (&breg)[NREG], const ALAS float* Sr, int lane, unsigned bstar, float& tie_v) {
    float mn = INFINITY, mx = -INFINITY;
#pragma unroll
    for (int i = 0; i < NREG; ++i) { const float f = Sr[64 * i + lane]; const bool in = (breg[i] == bstar); mn = fminf(mn, in ? f : INFINITY); mx = fmaxf(mx, in ? f : -INFINITY); }
    const float lo = wave_minf(mn), hi = wave_maxf(mx);
    if (!(hi > lo)) { tie_v = lo; return false; }
    const float scale = 255.5f / (hi - lo);
#pragma unroll
    for (int i = 0; i < NREG; ++i) { const unsigned b = (unsigned)((Sr[64 * i + lane] - lo) * scale); breg[i] = (breg[i] == bstar) ? (b > 255u ? 255u : b) + 1u : (breg[i] > bstar ? 0xFFFFFFFFu : 0u); }
    return true;
}
template <int I, int NREG> __device__ __forceinline__ void fin_words(const unsigned (&breg)[NREG], unsigned bstar, unsigned& wlo, unsigned& whi) {
    if constexpr (I < NREG) { const unsigned long long w = __ballot(breg[I] > bstar); wlane<I>(wlo, (unsigned)w); wlane<I>(whi, (unsigned)(w >> 32)); fin_words<I + 1, NREG>(breg, bstar, wlo, whi); }
}
template <int NREG>
__device__ __forceinline__ int select_hist(const ALAS float* Sr, int t, unsigned kmin, unsigned kmax, unsigned long long* bm, ALAS unsigned char* wl, int lane, float& tie_v) {
    ALAS unsigned* hist = (ALAS unsigned*)wl; ALAS unsigned* ckey = hist; ALAS unsigned short* cpos = (ALAS unsigned short*)(hist + 256); ALAS unsigned long long* mk64 = (ALAS unsigned long long*)(wl + 1536); ALAS unsigned* mk32 = (ALAS unsigned*)mk64;
    const float lo = unsortable(kmin), hi = unsortable(kmax);
    if (!(hi > lo)) { tie_v = lo; return 2; }
    unsigned breg[NREG];
    { const float scale = 255.5f / (hi - lo);
#pragma unroll
      for (int i = 0; i < NREG; ++i) { const unsigned b = (unsigned)((Sr[64 * i + lane] - lo) * scale); breg[i] = (64 * i + lane <= t) ? (b > 255u ? 255u : b) + 1u : 0u; } }
    unsigned wlo = 0u, whi = 0u, need = 256u, bstar = 0u, ncand = 0u;
    hist_level<NREG>(breg, hist, lane, need, bstar, ncand);
    if (ncand > 256u) { if (!hist_refine<NREG>(breg, Sr, lane, bstar, tie_v)) return 2; hist_level<NREG>(breg, hist, lane, need, bstar, ncand);
        if (ncand > 256u) { if (!hist_refine<NREG>(breg, Sr, lane, bstar, tie_v)) return 2; hist_level<NREG>(breg, hist, lane, need, bstar, ncand); if (ncand > 256u) return 1; } }
    fin_words<0, NREG>(breg, bstar, wlo, whi);
    if (lane < 32) mk64[lane] = ((unsigned long long)whi << 32) | wlo;
    unsigned base = 0u;
#pragma unroll
    for (int i = 0; i < NREG; ++i) {
        const unsigned long long eq = __ballot(breg[i] == bstar);
        if (eq != 0ull) { const unsigned pos = base + (unsigned)__builtin_amdgcn_mbcnt_hi((unsigned)(eq >> 32), __builtin_amdgcn_mbcnt_lo((unsigned)eq, 0u));
            if (breg[i] == bstar) { ckey[pos] = sortable(Sr[64 * i + lane]); cpos[pos] = (unsigned short)(64 * i + lane); }
            base += (unsigned)__builtin_popcountll(eq); } }
    unsigned ck[4], cp[4];
#pragma unroll
    for (int j = 0; j < 4; ++j) { const bool in = (64 * j + lane < (int)ncand); ck[j] = in ? ckey[64 * j + lane] : 0u; cp[j] = in ? (unsigned)cpos[64 * j + lane] : 0u; }
    unsigned T = 0u;
#pragma unroll 1
    for (int bit = 31; bit >= 0; --bit) { const unsigned x = T | (1u << bit);
        unsigned c = (unsigned)__builtin_popcountll(__ballot(ck[0] >= x));
        if (ncand > 64u) c += (unsigned)__builtin_popcountll(__ballot(ck[1] >= x)) + (unsigned)__builtin_popcountll(__ballot(ck[2] >= x)) + (unsigned)__builtin_popcountll(__ballot(ck[3] >= x));
        if (c >= need) T = x;
        if (c == need) break; }
    int need_eq = (int)need;
#pragma unroll
    for (int j = 0; j < 4; ++j) need_eq -= __builtin_popcountll(__ballot(ck[j] > T));
#pragma unroll
    for (int j = 0; j < 4; ++j) { const unsigned long long eqc = __ballot(ck[j] == T && 64 * j + lane < (int)ncand);
        const int rk = __builtin_amdgcn_mbcnt_hi((unsigned)(eqc >> 32), __builtin_amdgcn_mbcnt_lo((unsigned)eqc, 0u));
        if (64 * j + lane < (int)ncand && (ck[j] > T || (ck[j] == T && rk < need_eq))) __hip_atomic_fetch_or(mk32 + (cp[j] >> 5), 1u << (cp[j] & 31u), __ATOMIC_RELAXED, __HIP_MEMORY_SCOPE_WORKGROUP);
        need_eq -= __builtin_popcountll(eqc); }
    if (lane < 32) bm[lane] = mk64[lane];
    return 0;
}
template <int I, int NREG> __device__ __forceinline__ void ties_words(const ALAS float* Sr, int t, float v, int rem, int lane, unsigned& wlo, unsigned& whi) {
    if constexpr (I < NREG) { const float f = Sr[64 * I + lane]; const bool ok = (64 * I + lane <= t);
        const unsigned long long eq = __ballot(ok && f == v);
        const int rk = __builtin_amdgcn_mbcnt_hi((unsigned)(eq >> 32), __builtin_amdgcn_mbcnt_lo((unsigned)eq, 0u));
        const unsigned long long w = __ballot(ok && (f > v || (f == v && rk < rem)));
        wlane<I>(wlo, (unsigned)w); wlane<I>(whi, (unsigned)(w >> 32));
        const int take = __builtin_popcountll(eq); ties_words<I + 1, NREG>(Sr, t, v, rem > take ? rem - take : 0, lane, wlo, whi); }
}
template <int NREG>
__device__ __forceinline__ void select_ties(const ALAS float* Sr, int t, float v, unsigned long long* bm, int lane) {
    unsigned c = 0u;
#pragma unroll
    for (int i = 0; i < NREG; ++i) c += (64 * i + lane <= t && Sr[64 * i + lane] > v) ? 1u : 0u;
    const int rem = 256 - (int)wave_sum_u32(c);
    unsigned wlo = 0u, whi = 0u;
    ties_words<0, NREG>(Sr, t, v, rem, lane, wlo, whi);
    if (lane < 32) bm[lane] = ((unsigned long long)whi << 32) | wlo;
}
template <int NREG>
__device__ __forceinline__ void select_rows(const ALAS float* Sa, const ALAS float* Sb, int ta, unsigned long long* bm0, ALAS unsigned char* wl, int lane, int nreg, const ALAS unsigned* RMNr) {
    const unsigned kmna = RMNr[0] + 1u, kmxa = RMNr[16], kmnb = RMNr[1] + 1u, kmxb = RMNr[17];
    float va = 0.f, vb = 0.f;
    const int ra = select_hist<NREG>(Sa, ta, kmna, kmxa, bm0, wl, lane, va);
    const int rb = select_hist<NREG>(Sb, ta + 1, kmnb, kmxb, bm0 + 32, wl, lane, vb);
    if (ra == 2) select_ties<NREG>(Sa, ta, va, bm0, lane);
    if (rb == 2) select_ties<NREG>(Sb, ta + 1, vb, bm0 + 32, lane);
    if (ra == 1 || rb == 1) select2<NREG>(Sa, Sb, ta, bm0, bm0 + 32, lane, 80, nreg, RMNr);
}
__device__ __forceinline__ void idx_unit(int b, int qb16, const bf16_t* PO, const float* WI, unsigned long long* BM, ALAS unsigned char* lds, int probe = 0) {
    const int tid = threadIdx.x, lane = tid & 63, wave = __builtin_amdgcn_readfirstlane(tid >> 6), fr = lane & 15, fq = lane >> 4;
    const int t0 = qb16 * 16, tok0 = b * 2048, nk = t0 + 16, nt16 = qb16 + 1;
    unsigned long long* bm0 = BM + (size_t)(tok0 + t0 + 2 * wave) * 32;
    if (qb16 < 16) {
#pragma unroll 1
        for (int rr = 0; rr < 2; ++rr) { const int t = t0 + 2 * wave + rr;
            if (lane < 32) { const int base = 64 * lane; unsigned long long w = 0ull; if (t >= base + 63) w = ~0ull; else if (t >= base) w = (2ull << (t - base)) - 1ull; bm0[rr * 32 + lane] = w; } }
        return;
    }
    ALAS float* S = (ALAS float*)lds; ALAS unsigned* SU = (ALAS unsigned*)lds;
    ALAS unsigned* RMN = (ALAS unsigned*)(lds + 16 * SROW * 4); ALAS unsigned* RMX = RMN + 16;
    if (tid < 16) { RMN[tid] = 0xFFFFFFFFu; RMX[tid] = 0u; }
    __syncthreads();
    {
        unsigned mnk[4] = {0xFFFFFFFFu, 0xFFFFFFFFu, 0xFFFFFFFFu, 0xFFFFFFFFu}, mxk[4] = {0u, 0u, 0u, 0u};
        bf16x8 qa[8]; const bf16_t* qp = PO + (size_t)(tok0 + t0 + fr) * 1536 + 768 + fq * 8;
#pragma unroll
        for (int h = 0; h < 8; ++h) qa[h] = *(const bf16x8*)(qp + h * 32);
        float wv[4][8];
#pragma unroll
        for (int i = 0; i < 4; ++i) { const f32x4 w0 = *(const f32x4*)(WI + (size_t)(tok0 + t0 + 4 * fq + i) * 8), w1 = *(const f32x4*)(WI + (size_t)(tok0 + t0 + 4 * fq + i) * 8 + 4);
#pragma unroll
            for (int e = 0; e < 4; ++e) { wv[i][e] = w0[e]; wv[i][4 + e] = w1[e]; } }
        const bf16_t* kbase = PO + (size_t)(tok0 + fr) * 1536 + 1280 + fq * 8;
#pragma unroll 1
        for (int j0 = wave; j0 < nt16; j0 += 32) {
            bf16x8 kf[4];
#pragma unroll
            for (int c = 0; c < 4; ++c) { const int j = j0 + 8 * c, jc = j < nt16 ? j : nt16 - 1; kf[c] = *(const bf16x8*)(kbase + (size_t)(16 * jc) * 1536); }
#pragma unroll
            for (int c = 0; c < 4; ++c) { const int j = j0 + 8 * c;
                f32x4 sc = {0.f, 0.f, 0.f, 0.f};
#pragma unroll
                for (int h = 0; h < 8; ++h) { const f32x4 d = __builtin_amdgcn_mfma_f32_16x16x32_bf16(qa[h], kf[c], (f32x4){0.f, 0.f, 0.f, 0.f}, 0, 0, 0);
#pragma unroll
                    for (int i = 0; i < 4; ++i) sc[i] += fmaxf(d[i], 0.f) * wv[i][h]; }
                if (j < nt16) {
#pragma unroll
                    for (int i = 0; i < 4; ++i) { unsigned kx = sortable(sc[i]); if (16 * j + fr > t0 + 4 * fq + i) kx = 0u;
                        S[(4 * fq + i) * SROW + 16 * j + fr] = sc[i]; mnk[i] = min(mnk[i], kx - 1u); mxk[i] = max(mxk[i], kx); } } }
        }
#pragma unroll
        for (int i = 0; i < 4; ++i) { unsigned a = mnk[i], b = mxk[i];
#pragma unroll
            for (int o = 1; o < 16; o <<= 1) { a = min(a, (unsigned)__shfl_xor((int)a, o)); b = max(b, (unsigned)__shfl_xor((int)b, o)); }
            if (fr == 0) { __hip_atomic_fetch_min(RMN + 4 * fq + i, a, __ATOMIC_RELAXED, __HIP_MEMORY_SCOPE_WORKGROUP); __hip_atomic_fetch_max(RMX + 4 * fq + i, b, __ATOMIC_RELAXED, __HIP_MEMORY_SCOPE_WORKGROUP); } }
    }
    __syncthreads();
    if (!(probe & 4)) { const int r = 2 * wave, nreg = (nk + 63) >> 6; const ALAS float* Sa = S + r * SROW; const ALAS float* Sb = Sa + SROW;
      ALAS unsigned char* wl = lds + 16 * SROW * 4 + 128 + wave * 1792;
      if (nreg <= 8) select_rows<8>(Sa, Sb, t0 + r, bm0, wl, lane, nreg, RMN + r);
      else if (nreg <= 16) select_rows<16>(Sa, Sb, t0 + r, bm0, wl, lane, nreg, RMN + r);
      else if (nreg <= 24) select_rows<24>(Sa, Sb, t0 + r, bm0, wl, lane, nreg, RMN + r);
      else select_rows<32>(Sa, Sb, t0 + r, bm0, wl, lane, nreg, RMN + r); }
    __syncthreads();
}
#undef ALAS
}

constexpr int NWAVES = 8;
#ifndef MK_N_LAUNCHES
#define MK_N_LAUNCHES 1
#endif
constexpr int NPHASE = 13;
constexpr int N_LAUNCHES = MK_N_LAUNCHES;

constexpr int SEQ = 2048, NB = 16, M = NB * SEQ, D = 1024, FF = 4096;
constexpr int NE = 2304;
constexpr int NO = 1536;
constexpr float C2_64 = 0.125f * 1.4426950408889634f;
constexpr float C2_96 = 0.10206207261596577f * 1.4426950408889634f;

constexpr size_t MiB = 1u << 20;
constexpr size_t WS_CTL = 0, CTL_ZERO_BYTES = 64 * 1024;
constexpr size_t WS_ROPE = 1 * MiB;
constexpr size_t WS_BIAS = WS_ROPE + 256 * 1024;
constexpr size_t WS_FA = WS_BIAS + 64 * 1024;
constexpr size_t WS_F2 = WS_FA + 1 * MiB;
constexpr size_t WS_WI = WS_F2 + 1 * MiB;
constexpr size_t WS_SSQ = WS_WI + 1 * MiB;
constexpr size_t WS_SSKV = WS_SSQ + 512 * 1024;
constexpr size_t WS_SSA = 6 * MiB;
constexpr size_t WS_SSB = 8 * MiB;
constexpr size_t WS_W = 10 * MiB;
constexpr size_t W_INE = WS_W;
constexpr size_t W_OUTE = W_INE + (size_t)NE * D * 2;
constexpr size_t W_M1A = W_OUTE + (size_t)D * D * 2;
constexpr size_t W_M2A = W_M1A + (size_t)FF * D * 2;
constexpr size_t W_INO = W_M2A + (size_t)FF * D * 2;
constexpr size_t W_UQ = W_INO + (size_t)NO * D * 2;
constexpr size_t W_UKV = W_UQ + (size_t)768 * 256 * 2;
constexpr size_t W_OUTO = W_UKV + (size_t)1024 * 128 * 2;
constexpr size_t W_M1B = W_OUTO + (size_t)D * D * 2;
constexpr size_t W_M2B = W_M1B + (size_t)FF * D * 2;
constexpr size_t W_END = W_M2B + (size_t)FF * D * 2;
constexpr size_t WS_XB = 56 * MiB;
constexpr size_t WS_BIG = 120 * MiB;
constexpr size_t WS_PE = WS_BIG;
constexpr size_t WS_OE = WS_BIG + 144 * MiB;
constexpr size_t WS_H = WS_BIG;
constexpr size_t WS_PO = WS_BIG;
constexpr size_t WS_QD = WS_BIG + 96 * MiB;
constexpr size_t WS_KD = WS_BIG + 144 * MiB;
constexpr size_t WS_VD = WS_BIG + 192 * MiB;
constexpr size_t WS_OO = WS_BIG + 256 * MiB;
constexpr size_t WS_BM = WS_OO + 64 * MiB;
constexpr size_t WS_END = WS_BM + 8 * MiB;
static_assert(W_END <= WS_XB && WS_SSKV + 512 * 1024 <= WS_SSA, "d_ws map");
constexpr int CW_BAR = 1024;

constexpr int RING_BYTES = 131072;
constexpr int LDS_SCRATCH = 145920;
constexpr int LDSCTL_OFF = LDS_SCRATCH, MISC_OFF = LDSCTL_OFF + 320;
constexpr int LDS_BYTES = 147456;

#define GAS __attribute__((address_space(1)))
#define LAS __attribute__((address_space(3)))
typedef unsigned short bf16;
typedef unsigned v4u __attribute__((ext_vector_type(4)));
typedef float f32x4 __attribute__((ext_vector_type(4)));
typedef short bf16x8 __attribute__((ext_vector_type(8)));
typedef GAS unsigned gu32;
typedef GAS unsigned long long gu64;
#define RLX_AGENT __ATOMIC_RELAXED, __HIP_MEMORY_SCOPE_AGENT
#define LDS_WAIT() asm volatile("s_waitcnt lgkmcnt(0)" ::: "memory")
#define VM_WAIT() asm volatile("s_waitcnt vmcnt(0)" ::: "memory")
__device__ __forceinline__ unsigned long long rt() { return __builtin_amdgcn_s_memrealtime(); }
__device__ __forceinline__ unsigned f2bf(float f) { unsigned u = __builtin_bit_cast(unsigned, f); return (u + 0x7fffu + ((u >> 16) & 1u)) >> 16; }
__device__ __forceinline__ unsigned pk2(float lo, float hi) { return f2bf(lo) | (f2bf(hi) << 16); }

#define XB_TMO      128
#define XB_XCNT(j)  (256  + 64 * (j))
#define XB_XSUB(j)  (1280 + 64 * (j))
#define XB_XGEN(j)  (2304 + 64 * (j))
#define XB_TOP      3328
#define XB_TOPGEN   3392
#define XCD_BAR_WORDS 3456
#define XB_SPIN_CAP (1u << 18)

__device__ __forceinline__ unsigned xb_ld(unsigned* p)              { return __hip_atomic_load(p, __ATOMIC_RELAXED, __HIP_MEMORY_SCOPE_AGENT); }
__device__ __forceinline__ unsigned xb_add(unsigned* p, unsigned v) { return __hip_atomic_fetch_add(p, v, __ATOMIC_RELAXED, __HIP_MEMORY_SCOPE_AGENT); }
__device__ __forceinline__ unsigned xb_xcc_id() { return (unsigned)__builtin_amdgcn_s_getreg((3 << 11) | 20) & 0xFu; }
#define XB_SPIN(cond, bar) do { unsigned _sp = 0; while (cond) { __builtin_amdgcn_s_sleep(1); \
    if ((++_sp & 255u) == 0u) { if (xb_ld(&(bar)[XB_TMO])) break; if (_sp > XB_SPIN_CAP) { atomicAdd(&(bar)[XB_TMO], 1u); break; } } } } while (0)

struct XcdBarrier {
    unsigned* bar; unsigned x;
    volatile LAS unsigned* st;
};

__device__ __forceinline__ XcdBarrier xcd_barrier_post(unsigned* bar, volatile LAS unsigned* st) {
    XcdBarrier b; b.bar = bar; b.x = xb_xcc_id(); b.st = st;
    if (threadIdx.x == 0) (void)xb_add(&bar[XB_XCNT(b.x)], 1u);
    return b;
}
__device__ __forceinline__ void xcd_barrier_complete(unsigned* bar, unsigned x, unsigned& nloc, unsigned& nx) {
    const unsigned G = gridDim.x * gridDim.y * gridDim.z;
    unsigned sum, cnt, mine, sp = 0u;
    for (;;) {
        sum = 0u; cnt = 0u; mine = 0u;
#pragma unroll
        for (unsigned j = 0; j < 16; ++j) { const unsigned c = xb_ld(&bar[XB_XCNT(j)]); sum += c; cnt += (c > 0u) ? 1u : 0u; mine = (j == x) ? c : mine; }
        if (sum == G) break;
        __builtin_amdgcn_s_sleep(1);
        if ((++sp & 255u) == 0u) { if (xb_ld(&bar[XB_TMO])) break; if (sp > XB_SPIN_CAP) { atomicAdd(&bar[XB_TMO], 1u); break; } }
    }
    nloc = mine > 0u ? mine : 1u; nx = cnt > 0u ? cnt : 1u;
}

__device__ __forceinline__ void xcd_barrier(const XcdBarrier& b) {
    asm volatile("s_waitcnt vmcnt(0)" ::: "memory");
    __syncthreads();
    if (threadIdx.x == 0) {
        unsigned* bar = b.bar;
        __builtin_amdgcn_s_waitcnt(0);
        unsigned nloc = b.st[0], nx = b.st[1];
        if (nloc == 0u) { xcd_barrier_complete(bar, b.x, nloc, nx); b.st[0] = nloc; b.st[1] = nx; }
        const unsigned old = xb_add(&bar[XB_XSUB(b.x)], 1u);
        const unsigned gen = old / nloc;
        if (old + 1u == (gen + 1u) * nloc) {
            __builtin_amdgcn_fence(__ATOMIC_RELEASE, "agent");
            asm volatile("s_waitcnt vmcnt(0)" ::: "memory");
            const unsigned og = xb_add(&bar[XB_TOP], 1u);
            const unsigned tg = og / nx;
            if (og + 1u == (tg + 1u) * nx) xb_add(&bar[XB_TOPGEN], 1u);
            else XB_SPIN(xb_ld(&bar[XB_TOPGEN]) == tg, bar);
            __builtin_amdgcn_fence(__ATOMIC_ACQUIRE, "agent");
            xb_add(&bar[XB_XGEN(b.x)], 1u);
            asm volatile("s_waitcnt vmcnt(0)" ::: "memory");
        } else {
            XB_SPIN(xb_ld(&bar[XB_XGEN(b.x)]) == gen, bar);
            __builtin_amdgcn_fence(__ATOMIC_ACQUIRE, "agent");
            asm volatile("s_waitcnt vmcnt(0)" ::: "memory");
        }
    }
    __syncthreads();
}

__device__ __forceinline__ float wave_sum(float v) {
#pragma unroll
    for (int o = 1; o < 64; o <<= 1) v += __shfl_xor(v, o);
    return v;
}
template <int WHICH> __device__ __forceinline__ int srccol(int n) {
    if (WHICH == 0) return n;
    if (WHICH == 1) return n < 1536 ? n : n + 8;
    if (n < 512) return n;
    if (n < 768) return 936 + (n - 512);
    if (n < 1024) return 640 + (n - 768);
    if (n < 1152) return 1192 + (n - 1024);
    if (n < 1216) return 512 + (n - 1152);
    if (n < 1280) return 576 + (n - 1216);
    if (n < 1312) return 896 + (n - 1280);
    if (n < 1344) return 1320 + (n - 1312);
    if (n < 1352) return 928 + (n - 1344);
    return -1;
}
template <int WHICH>
__device__ __forceinline__ void p0_transpose_item(const float* W, int K, int Nsrc, int Ndst, const float* gain, bf16* WT, LAS float* scr, int item, int lane) {
    const int nblk = Ndst / 32, kb = item / nblk, nb = item % nblk, k0 = 64 * kb, n0 = 32 * nb;
    const int sc = srccol<WHICH>(n0 + (lane & 31));
#pragma unroll
    for (int i = 0; i < 32; ++i) { const int kk = 2 * i + (lane >> 5); float v = 0.f; if (sc >= 0) { v = W[(size_t)(k0 + kk) * Nsrc + sc]; if (gain) v *= gain[k0 + kk]; } scr[kk * 33 + (lane & 31)] = v; }
    LDS_WAIT(); asm volatile("" ::: "memory");
    const int c = lane & 7;
#pragma unroll
    for (int j = 0; j < 4; ++j) { const int n = (lane >> 3) + 8 * j; const LAS float* s = scr + (8 * c) * 33 + n;
        v4u o; o.x = pk2(s[0 * 33], s[1 * 33]); o.y = pk2(s[2 * 33], s[3 * 33]); o.z = pk2(s[4 * 33], s[5 * 33]); o.w = pk2(s[6 * 33], s[7 * 33]);
        *(GAS v4u*)(WT + (size_t)(n0 + n) * K + k0 + 8 * c) = o; }
    LDS_WAIT(); asm volatile("" ::: "memory");
}
struct TrSrc { const float* W; const float* gain; bf16* WT; int K, Nsrc, Ndst, which, item; };
__device__ __forceinline__ int srccol_rt(int which, int n) { return which == 2 ? srccol<2>(n) : (which == 1 ? srccol<1>(n) : n); }
__device__ __forceinline__ void tr_issue(const TrSrc& t, LAS unsigned char* tile, int lane) {
    const int nblk = t.Ndst / 32, kb = t.item / nblk, nb = t.item % nblk, k0 = 64 * kb, n0 = 32 * nb;
    const int sc = srccol_rt(t.which, n0 + 4 * (lane & 7));
    const float* src = t.W + (size_t)(k0 + (lane >> 3)) * t.Nsrc + (sc < 0 ? 0 : sc);
    if (t.gain) __builtin_amdgcn_global_load_lds((const GAS unsigned*)(t.gain + k0 + lane), (LAS unsigned*)(tile + 8192), 4, 0, 0);
#pragma unroll
    for (int i = 0; i < 8; ++i) __builtin_amdgcn_global_load_lds((const GAS unsigned*)(src + (size_t)(8 * i) * t.Nsrc), (LAS unsigned*)(tile + i * 1024), 16, 0, 0);
}
__device__ __forceinline__ void tr_finish(const TrSrc& t, const LAS unsigned char* tile, int lane, bool next_in_flight) {
    const int nblk = t.Ndst / 32, kb = t.item / nblk, nb = t.item % nblk, k0 = 64 * kb, n0 = 32 * nb;
    if (next_in_flight) asm volatile("s_waitcnt vmcnt(8)" ::: "memory"); else asm volatile("s_waitcnt vmcnt(0)" ::: "memory");
    const int c = lane & 7; const LAS float* tl = (const LAS float*)tile;
    f32x4 g0 = {1.f, 1.f, 1.f, 1.f}, g1 = {1.f, 1.f, 1.f, 1.f};
    if (t.gain) { g0 = *(const LAS f32x4*)(tl + 2048 + 8 * c); g1 = *(const LAS f32x4*)(tl + 2048 + 8 * c + 4); }
#pragma unroll
    for (int j = 0; j < 4; ++j) { const int n = (lane >> 3) + 8 * j; const LAS float* s = tl + (8 * c) * 32 + n; const bool z = srccol_rt(t.which, n0 + n) < 0;
        v4u o; o.x = pk2(s[0] * g0[0], s[32] * g0[1]); o.y = pk2(s[64] * g0[2], s[96] * g0[3]); o.z = pk2(s[128] * g1[0], s[160] * g1[1]); o.w = pk2(s[192] * g1[2], s[224] * g1[3]);
        if (z) o = (v4u){0u, 0u, 0u, 0u};
        *(GAS v4u*)(t.WT + (size_t)(n0 + n) * t.K + k0 + 8 * c) = o; }
    asm volatile("s_waitcnt lgkmcnt(0)" ::: "memory");
}
__device__ __forceinline__ int t5_bucket(int n) {
    if (n < 16) return n;
    const float nf = (float)n; int large = 16 + (int)(logf(fmaxf(nf, 16.f) / 16.f) / logf(8.f) * 16.f);
    return large < 31 ? large : 31;
}

struct Args { const float* in[18]; float* out; unsigned char* ws; int ph_lo, ph_hi, li, pad; };
__global__ void __launch_bounds__(NWAVES * 64, 2) fwd_kernel(Args args) {
    extern __shared__ __attribute__((aligned(16))) unsigned char lds_raw[];
    LAS unsigned char* lds = (LAS unsigned char*)lds_raw;
    volatile LAS unsigned* MISC = (volatile LAS unsigned*)(lds + MISC_OFF);
    const int tid = threadIdx.x, lane = tid & 63, wave = __builtin_amdgcn_readfirstlane(tid >> 6);
    const int G = gridDim.x, bx = blockIdx.x, vcu = (G % 8 == 0) ? (bx % 8) * (G / 8) + bx / 8 : bx;
    unsigned char* ws = args.ws;
    gu32* ctl = (gu32*)(ws + WS_CTL);
    const float* x_in = args.in[0];
    float* out = args.out;
    bf16* XB = (bf16*)(ws + WS_XB); bf16* PE = (bf16*)(ws + WS_PE); bf16* OE = (bf16*)(ws + WS_OE); bf16* HB = (bf16*)(ws + WS_H);
    bf16* PO = (bf16*)(ws + WS_PO); bf16* QD = (bf16*)(ws + WS_QD); bf16* KD = (bf16*)(ws + WS_KD); bf16* VD = (bf16*)(ws + WS_VD); bf16* OO = (bf16*)(ws + WS_OO);
    unsigned long long* BMg = (unsigned long long*)(ws + WS_BM);
    float* ROPE = (float*)(ws + WS_ROPE); float* BIAS = (float*)(ws + WS_BIAS); float* FA = (float*)(ws + WS_FA); float* F2 = (float*)(ws + WS_F2); float* WI = (float*)(ws + WS_WI);
    float* SSQ = (float*)(ws + WS_SSQ); float* SSKV = (float*)(ws + WS_SSKV); float* SSA = (float*)(ws + WS_SSA); float* SSB = (float*)(ws + WS_SSB);

    for (int u = tid; u < (LDS_BYTES - LDSCTL_OFF) / 4; u += NWAVES * 64) ((LAS unsigned*)(lds + LDSCTL_OFF))[u] = 0u;
    __syncthreads();
    XcdBarrier bar; bar.bar = (unsigned*)(ctl + CW_BAR); bar.x = 0; bar.st = nullptr;
    if (N_LAUNCHES == 1) bar = xcd_barrier_post((unsigned*)(ctl + CW_BAR), MISC + 8);
#define GRID_BAR() do { if (N_LAUNCHES == 1) xcd_barrier(bar); } while (0)
    const int lo = args.ph_lo, hi = args.ph_hi;
#ifndef PH_MASK
#define PH_MASK 0x1FFF
#endif
#ifndef REP_MASK
#define REP_MASK 0
#endif
#define IN(k) ((((PH_MASK) >> (k)) & 1) && lo <= (k) && (k) < hi)
#ifndef TS_PHASE
#define TS_PHASE -1
#endif
#ifndef TS_A
#define TS_A TS_PHASE
#define TS_B (TS_PHASE + 1)
#endif
#define STAMP(k) do { if (TS_PHASE >= 0 && bx == 0 && tid == 0) ((unsigned long long*)(ctl + 512))[k] = __builtin_amdgcn_s_memrealtime(); } while (0)
#ifndef TS_BLK
#define TS_BLK 0
#endif
#define STAMPB(k) do { if (TS_PHASE >= 0 && bx == TS_BLK && tid == 0) ((unsigned long long*)(ctl + 512))[k] = __builtin_amdgcn_s_memrealtime(); } while (0)
#define SEAM(k) do { if (IN(k) && IN((k) + 1)) GRID_BAR(); STAMP((k) + 1); } while (0)
    STAMP(0);

    if (IN(0)) for (int rep_ = 0; rep_ <= ((REP_MASK >> 0) & 1); ++rep_) { if (rep_) GRID_BAR();
        LAS float* scr = (LAS float*)(lds + wave * 16384);
        const int gw = vcu * NWAVES + wave, NGW = G * NWAVES;
        const float* nmE = args.in[1]; const float* winE = args.in[2]; const float* woutE = args.in[5]; const float* nmO = args.in[6]; const float* winO = args.in[7];
        const float* ncq = args.in[8]; const float* nckv = args.in[9]; const float* wuq = args.in[10]; const float* wukv = args.in[11]; const float* woutO = args.in[12];
        const float* nmlp = args.in[13]; const float* w1 = args.in[14]; const float* w2 = args.in[15];
        constexpr int I0 = 16 * 72;
        { constexpr int J1 = 16 * 32, J2 = 16 * 128, J3 = 64 * 32, J4 = 16 * 48, J5 = 4 * 24, J6 = 2 * 32, NITEMS = I0 + J1 + J2 + J3 + J4 + J5 + J6 + J1 + J2 + J3;
#define TR_DECODE(r_, t_) do { int r = (r_); \
            if (r < I0) { t_ = TrSrc{winE, nmE, (bf16*)(ws + W_INE), 1024, 2312, NE, 1, r}; break; } r -= I0; \
            if (r < J1) { t_ = TrSrc{woutE, nullptr, (bf16*)(ws + W_OUTE), 1024, 1024, 1024, 0, r}; break; } r -= J1; \
            if (r < J2) { t_ = TrSrc{w1, nmlp, (bf16*)(ws + W_M1A), 1024, 4096, 4096, 0, r}; break; } r -= J2; \
            if (r < J3) { t_ = TrSrc{w2, nullptr, (bf16*)(ws + W_M2A), 4096, 1024, 1024, 0, r}; break; } r -= J3; \
            if (r < J4) { t_ = TrSrc{winO, nmO, (bf16*)(ws + W_INO), 1024, 1352, NO, 2, r}; break; } r -= J4; \
            if (r < J5) { t_ = TrSrc{wuq, ncq, (bf16*)(ws + W_UQ), 256, 768, 768, 0, r}; break; } r -= J5; \
            if (r < J6) { t_ = TrSrc{wukv, nckv, (bf16*)(ws + W_UKV), 128, 1024, 1024, 0, r}; break; } r -= J6; \
            if (r < J1) { t_ = TrSrc{woutO, nullptr, (bf16*)(ws + W_OUTO), 1024, 1024, 1024, 0, r}; break; } r -= J1; \
            if (r < J2) { t_ = TrSrc{w1 + (size_t)1024 * 4096, nmlp + 1024, (bf16*)(ws + W_M1B), 1024, 4096, 4096, 0, r}; break; } r -= J2; \
            t_ = TrSrc{w2 + (size_t)4096 * 1024, nullptr, (bf16*)(ws + W_M2B), 4096, 1024, 1024, 0, r}; } while (0)
          LAS unsigned char* t0_ = lds + wave * 16896; LAS unsigned char* t1_ = t0_ + 8448;
          TrSrc ca, cb; int it = gw;
          if (it < NITEMS) { TR_DECODE(it, ca); tr_issue(ca, t0_, lane); }
          while (it < NITEMS) {
              const int nx = it + NGW; const bool more = nx < NITEMS;
              if (more) { TR_DECODE(nx, cb); tr_issue(cb, t1_, lane); }
              tr_finish(ca, t0_, lane, more);
              it = nx; if (!more) break;
              const int nx2 = it + NGW; const bool more2 = nx2 < NITEMS;
              if (more2) { TR_DECODE(nx2, ca); tr_issue(ca, t0_, lane); }
              tr_finish(cb, t1_, lane, more2);
              it = nx2; }
#undef TR_DECODE
        }
        STAMPB(23);
        { const int gt = vcu * (NWAVES * 64) + tid;
          if (gt < 2048 * 16) { const int pos = gt >> 4, i = gt & 15; const float inv = exp2f(-(float)i * 0.83048202372184058696f);
              const float ang = (float)pos * inv; float rev = ang * 0.15915494309189533577f; rev -= floorf(rev);
              ROPE[2 * gt] = __builtin_amdgcn_cosf(rev); ROPE[2 * gt + 1] = __builtin_amdgcn_sinf(rev); }
          if (gt < 2048) { const int which = gt >> 10, h = (gt >> 7) & 7, d = gt & 127; float v = args.in[16][t5_bucket(d) * 16 + which * 8 + h]; if (which) v -= args.in[16][31 * 16 + 8 + h]; BIAS[gt] = v * att::LOG2E; } }
        STAMPB(24);
        { float wf[16][8];
#pragma unroll
          for (int j = 0; j < 4; ++j)
#pragma unroll
              for (int e = 0; e < 4; ++e) { const int k = 256 * j + 4 * lane + e; const float gk = nmE[k];
#pragma unroll
                  for (int c = 0; c < 8; ++c) wf[j * 4 + e][c] = winE[(size_t)k * 2312 + 1536 + c] * gk; }
          f32x4 vn[4];
          if (gw < M) { const GAS f32x4* xr = (const GAS f32x4*)(x_in + (size_t)gw * D) + lane;
#pragma unroll
              for (int j = 0; j < 4; ++j) vn[j] = xr[64 * j]; }
          for (int m = gw; m < M; m += NGW) {
              f32x4 v[4]; float ss = 0.f;
#pragma unroll
              for (int j = 0; j < 4; ++j) { v[j] = vn[j]; ss += (v[j].x * v[j].x + v[j].y * v[j].y) + (v[j].z * v[j].z + v[j].w * v[j].w); }
              if (m + NGW < M) { const GAS f32x4* xr = (const GAS f32x4*)(x_in + (size_t)(m + NGW) * D) + lane;
#pragma unroll
                  for (int j = 0; j < 4; ++j) vn[j] = xr[64 * j]; }
              ss = wave_sum(ss);
              GAS unsigned long long* o8 = (GAS unsigned long long*)(XB + (size_t)m * D) + lane;
#pragma unroll
              for (int j = 0; j < 4; ++j) o8[64 * j] = (unsigned long long)pk2(v[j].x, v[j].y) | ((unsigned long long)pk2(v[j].z, v[j].w) << 32);
              float a8[8];
#pragma unroll
              for (int c = 0; c < 8; ++c) { float a = 0.f;
#pragma unroll
                  for (int j = 0; j < 4; ++j) a += (v[j].x * wf[j * 4][c] + v[j].y * wf[j * 4 + 1][c]) + (v[j].z * wf[j * 4 + 2][c] + v[j].w * wf[j * 4 + 3][c]);
                  a8[c] = a; }
              float a4[4], a2[2], a1;
              { const bool hb = (lane & 32) != 0;
#pragma unroll
                for (int i = 0; i < 4; ++i) { const float snd = hb ? a8[i] : a8[i + 4]; a4[i] = (hb ? a8[i + 4] : a8[i]) + __shfl_xor(snd, 32); } }
              { const bool hb = (lane & 16) != 0;
#pragma unroll
                for (int i = 0; i < 2; ++i) { const float snd = hb ? a4[i] : a4[i + 2]; a2[i] = (hb ? a4[i + 2] : a4[i]) + __shfl_xor(snd, 16); } }
              { const bool hb = (lane & 8) != 0; const float snd = hb ? a2[0] : a2[1]; a1 = (hb ? a2[1] : a2[0]) + __shfl_xor(snd, 8); }
              a1 += __shfl_xor(a1, 4); a1 += __shfl_xor(a1, 2); a1 += __shfl_xor(a1, 1);
              const float rstd = 1.0f / sqrtf(ss * (1.0f / 1024.0f) + 1e-6f);
              if ((lane & 7) == 0) FA[(size_t)m * 8 + (lane >> 3)] = a1 * rstd;
              if (lane < 16) SSA[(size_t)m * 16 + lane] = (lane == 0) ? ss : 0.f;
          } }
    }
    SEAM(0);
    if (IN(1)) for (int rep_ = 0; rep_ <= ((REP_MASK >> 1) & 1); ++rep_) { if (rep_) GRID_BAR();
        if (bx < 16) {
            const int b = bx, h = wave; const float bf = args.in[3][h]; float pre[32]; float run = 0.f;
#pragma unroll
            for (int i = 0; i < 32; ++i) { const float f = FA[(size_t)(b * SEQ + 32 * lane + i) * 8 + h] + bf; const float ls = fminf(f, 0.f) - log1pf(expf(-fabsf(f))); run += ls; pre[i] = run; }
            float incl = run;
#pragma unroll
            for (int o = 1; o < 64; o <<= 1) { const float t = __shfl_up(incl, o); if (lane >= o) incl += t; }
            const float excl = incl - run; float* dst = F2 + (size_t)(b * 8 + h) * SEQ + 32 * lane;
#pragma unroll
            for (int i = 0; i < 32; ++i) dst[i] = (excl + pre[i]) * att::LOG2E;
        }
        pg8::Gemm g{XB, (const bf16*)(ws + W_INE), M, NE, D, D}; pg8::StaticOrder S; S.init(M, NE, G, bx);
        pg8::EpiNormBf16<0> E{PE, NE, SSA, 0xC3u, C2_64};
        pg8::gemm_phase<pg8::EpiNormBf16<0>, pg8::StaticOrder, true, true>(lds, g, S, E);
    }
    SEAM(1);
    if (IN(2)) for (int rep_ = 0; rep_ <= ((REP_MASK >> 2) & 1); ++rep_) { if (rep_) GRID_BAR();
        for (int i = tid; i < 2048; i += NWAVES * 64) ((LAS float*)(lds + att::BIAS_LDS_OFF))[i] = BIAS[i];
        __syncthreads();
        for (int p = vcu; p < 512; p += G) { const int bh = p >> 2, s = p & 3, b = bh >> 3, h = bh & 7;
            for (int z = 0; z < 2; ++z) { const int qb = z ? s : 7 - s;
                att::AU u; u.Q = PE + h * 64; u.ldq = NE; u.K = PE + 512 + h * 64; u.ldk = NE; u.V = PE + 1024 + h * 64; u.ldv = NE; u.O = OE + h * 64; u.ldo = D;
                u.tok0 = b * SEQ; u.qpos = qb * 256 + wave * 32; u.t_lo = 0; u.t_hi = qb * 4 + 4; u.F2 = F2 + (size_t)(b * 8 + h) * SEQ; u.cb = u.F2[qb * 256];
                u.bias = nullptr; u.sink2 = 0.f; u.bm = nullptr;
                att::attn_unit<64, 0>(u, lds); } }
        for (int idx = vcu; idx < 1024; idx += G) { const int half = idx & 1, n = (idx >> 1) & 15, kvh = (idx >> 5) & 1, b = idx >> 6;
            const int hq = kvh * 4 + half * 2 + (wave >> 2);
            att::AU u; u.Q = PE + 1536 + hq * 64; u.ldq = NE; u.K = PE + 2048 + kvh * 64; u.ldk = NE; u.V = PE + 2176 + kvh * 64; u.ldv = NE; u.O = OE + 512 + hq * 64; u.ldo = D;
            u.tok0 = b * SEQ; u.qpos = n * 128 + (wave & 3) * 32; u.t_lo = n > 0 ? 2 * n - 2 : 0; u.t_hi = 2 * n + 2; u.F2 = nullptr; u.cb = 0.f;
            u.bias = (const LAS float*)(lds + att::BIAS_LDS_OFF) + hq * 128; u.sink2 = args.in[4][hq] * att::LOG2E; u.bm = nullptr;
            att::attn_unit<64, 1>(u, lds); }
    }
    SEAM(2);
    if (IN(3)) for (int rep_ = 0; rep_ <= ((REP_MASK >> 3) & 1); ++rep_) { if (rep_) GRID_BAR();
        pg8::Gemm g{OE, (const bf16*)(ws + W_OUTE), M, D, D, D}; pg8::StaticOrder S; S.init(M, D, G, bx);
        pg8::EpiResid E{XB, (args.pad & 32) ? OO : XB, (args.pad & 32) ? (float*)BMg : SSB};
        pg8::gemm_phase<pg8::EpiResid, pg8::StaticOrder, true, true>(lds, g, S, E);
    }
    SEAM(3);
    if (IN(4)) for (int rep_ = 0; rep_ <= ((REP_MASK >> 4) & 1); ++rep_) { if (rep_) GRID_BAR();
        pg8::Gemm g{XB, (const bf16*)(ws + W_M1A), M, FF, D, D}; pg8::StaticOrder S; S.init(M, FF, G, bx);
        pg8::EpiNormBf16<1> E{HB, FF, SSB, 0u, 1.f};
        pg8::gemm_phase<pg8::EpiNormBf16<1>, pg8::StaticOrder, true, true>(lds, g, S, E);
    }
    SEAM(4);
    if (IN(5)) for (int rep_ = 0; rep_ <= ((REP_MASK >> 5) & 1); ++rep_) { if (rep_) GRID_BAR();
        pg8::Gemm g{HB, (const bf16*)(ws + W_M2A), M, D, FF, FF}; pg8::StaticOrder S; S.init(M, D, G, bx);
        pg8::EpiResid E{XB, (args.pad & 32) ? OO : XB, (args.pad & 32) ? (float*)BMg : SSA};
        pg8::gemm_phase<pg8::EpiResid, pg8::StaticOrder, true, true>(lds, g, S, E);
    }
    SEAM(5);
    if (IN(6)) for (int rep_ = 0; rep_ <= ((REP_MASK >> 6) & 1); ++rep_) { if (rep_) GRID_BAR();
        pg8::Gemm g{XB, (const bf16*)(ws + W_INO), M, NO, D, D}; pg8::StaticOrder S; S.init(M, NO, G, bx);
        pg8::EpiInOdd E{PO, SSA, C2_64, SSQ, SSKV, KD, WI, ROPE};
        pg8::gemm_phase<pg8::EpiInOdd, pg8::StaticOrder, true, true>(lds, g, S, E);
    }
    SEAM(6);
    if (IN(7)) for (int rep_ = 0; rep_ <= ((REP_MASK >> 7) & 1); ++rep_) { if (rep_) GRID_BAR();
        if (!(args.pad & 1)) {
        { int kq_ = 256; asm volatile("" : "+s"(kq_)); pg8::Gemm g{PO + 512, (const bf16*)(ws + W_UQ), M, 768, kq_, NO}; pg8::StaticOrder S; S.init(M, 768, G, bx);
          pg8::EpiUq E{QD, SSQ, C2_96, ROPE};
          pg8::gemm_phase<pg8::EpiUq, pg8::StaticOrder, true, true>(lds, g, S, E); }
        STAMPB(20);
        { int kk_ = 128; asm volatile("" : "+s"(kk_)); pg8::Gemm g{PO + 1024, (const bf16*)(ws + W_UKV), M, 1024, kk_, NO}; pg8::StaticOrder S; S.init(M, 1024, G, bx);
          pg8::EpiUkv E{KD, VD, SSKV};
          pg8::gemm_phase<pg8::EpiUkv, pg8::StaticOrder, true, true>(lds, g, S, E); }
        STAMPB(21);
        }
        __syncthreads();
        if (!(args.pad & 2))
        for (;;) {
            if (tid == 0) MISC[16] = __hip_atomic_fetch_add((unsigned*)(ctl + 300), 1u, __ATOMIC_RELAXED, __HIP_MEMORY_SCOPE_AGENT);
            __syncthreads();
            const unsigned ui = MISC[16];
            __syncthreads();
            if (ui >= 2048u) break;
            att::idx_unit((int)(ui & 15u), 127 - (int)(ui >> 4), PO, WI, (args.pad & 8) ? (unsigned long long*)OO : BMg, lds, args.pad); }
    }
    STAMPB(22);
    SEAM(7);
    if (IN(8)) for (int rep_ = 0; rep_ <= ((REP_MASK >> 8) & 1); ++rep_) { if (rep_) GRID_BAR();
        for (int i = tid; i < 2048; i += NWAVES * 64) ((LAS float*)(lds + att::BIAS_LDS_OFF))[i] = BIAS[i];
        __syncthreads();
        for (int p = vcu; p < 512; p += G) { const int b = p >> 5, jp = p & 31;
            for (int z = 0; z < 2; ++z) { const int j = z ? jp : 63 - jp; const int hq = wave;
                att::AU u; u.Q = PO + hq * 64; u.ldq = NO; u.K = PO + 1152; u.ldk = NO; u.V = PO + 1216; u.ldv = NO; u.O = OO + hq * 64; u.ldo = D;
                u.tok0 = b * SEQ; u.qpos = 32 * j; u.t_lo = 0; u.t_hi = (j >> 1) + 1; u.F2 = nullptr; u.cb = 0.f;
                u.bias = (const LAS float*)(lds + att::BIAS_LDS_OFF) + 1024 + hq * 128; u.sink2 = 0.f; u.bm = BMg + (size_t)b * SEQ * 32;
                att::attn_unit<64, 2>(u, lds); } }
        for (int p = vcu; p < 512; p += G) { const int bh = p >> 2, s = p & 3, b = bh >> 3, h = bh & 7;
            for (int z = 0; z < 2; ++z) { const int qb = z ? s : 7 - s;
                att::AU u; u.Q = QD + h * 96; u.ldq = 768; u.K = KD + h * 96; u.ldk = 768; u.V = VD + h * 64; u.ldv = 512; u.O = OO + 512 + h * 64; u.ldo = D;
                u.tok0 = b * SEQ; u.qpos = qb * 256 + wave * 32; u.t_lo = 0; u.t_hi = qb * 4 + 4; u.F2 = nullptr; u.cb = 0.f; u.bias = nullptr; u.sink2 = 0.f; u.bm = nullptr;
                att::attn_unit<96, 3>(u, lds); } }
    }
    SEAM(8);
    if (IN(9)) for (int rep_ = 0; rep_ <= ((REP_MASK >> 9) & 1); ++rep_) { if (rep_) GRID_BAR();
        pg8::Gemm g{OO, (const bf16*)(ws + W_OUTO), M, D, D, D}; pg8::StaticOrder S; S.init(M, D, G, bx);
        pg8::EpiResid E{XB, (args.pad & 32) ? OO : XB, (args.pad & 32) ? (float*)BMg : SSB};
        pg8::gemm_phase<pg8::EpiResid, pg8::StaticOrder, true, true>(lds, g, S, E);
    }
    SEAM(9);
    if (IN(10)) for (int rep_ = 0; rep_ <= ((REP_MASK >> 10) & 1); ++rep_) { if (rep_) GRID_BAR();
        pg8::Gemm g{XB, (const bf16*)(ws + W_M1B), M, FF, D, D}; pg8::StaticOrder S; S.init(M, FF, G, bx);
        pg8::EpiNormBf16<1> E{HB, FF, SSB, 0u, 1.f};
        pg8::gemm_phase<pg8::EpiNormBf16<1>, pg8::StaticOrder, true, true>(lds, g, S, E);
    }
    SEAM(10);
    if (IN(11)) for (int rep_ = 0; rep_ <= ((REP_MASK >> 11) & 1); ++rep_) { if (rep_) GRID_BAR();
        pg8::Gemm g{HB, (const bf16*)(ws + W_M2B), M, D, FF, FF}; pg8::StaticOrder S; S.init(M, D, G, bx);
        pg8::EpiResid E{XB, (args.pad & 32) ? OO : XB, (args.pad & 32) ? (float*)BMg : SSA};
        pg8::gemm_phase<pg8::EpiResid, pg8::StaticOrder, true, true>(lds, g, S, E);
    }
    SEAM(11);
    if (IN(12)) for (int rep_ = 0; rep_ <= ((REP_MASK >> 12) & 1); ++rep_) { if (rep_) GRID_BAR();
        const int gw = vcu * NWAVES + wave, NGW = G * NWAVES; const float* gf = args.in[17];
        f32x4 gv[4];
#pragma unroll
        for (int j = 0; j < 4; ++j) gv[j] = *((const f32x4*)gf + lane + 64 * j);
        for (int m = gw; m < M; m += NGW) {
            float s = (lane < 16) ? SSA[(size_t)m * 16 + lane] : 0.f; s = wave_sum(s);
            const float rstd = 1.0f / sqrtf(s * (1.0f / 1024.0f) + 1e-6f);
            const GAS unsigned long long* xr = (const GAS unsigned long long*)(XB + (size_t)m * D) + lane;
            GAS f32x4* orow = (GAS f32x4*)(out + (size_t)m * D) + lane;
#pragma unroll
            for (int j = 0; j < 4; ++j) { const unsigned long long w = xr[64 * j]; const unsigned lo = (unsigned)w, hi = (unsigned)(w >> 32);
                f32x4 v = {__uint_as_float(lo << 16), __uint_as_float(lo & 0xFFFF0000u), __uint_as_float(hi << 16), __uint_as_float(hi & 0xFFFF0000u)};
                orow[64 * j] = v * rstd * gv[j]; }
        }
    }
    if (TS_PHASE >= 0 && N_LAUNCHES == 1) {
        GRID_BAR();
        if (bx == 0 && tid == 0) { unsigned long long* ts_ = (unsigned long long*)(ctl + 512); ts_[13] = __builtin_amdgcn_s_memrealtime(); out[0] += (float)(ts_[TS_B] - ts_[TS_A]) * 0.0001f; }
    }
#undef IN
#undef SEAM
#undef GRID_BAR
}

extern "C" void kernel_launch(void* const* d_in, const int* in_sizes, int n_in, void* d_out, int out_size, void* d_ws, size_t ws_size, hipStream_t stream) {
    static int grid = 0;
    if (grid == 0) {
        if (n_in != 18 || in_sizes[0] != M * D || out_size != M * D || ws_size < WS_END) { fprintf(stderr, "kernel_launch: shape/workspace mismatch: n_in %d in0 %d out %d ws %zu (need %zu)\n", n_in, n_in > 0 ? in_sizes[0] : -1, out_size, ws_size, (size_t)WS_END); grid = -1; return; }
        int dev = 0, cus = 0, per_cu = 0;
        if (hipGetDevice(&dev) != hipSuccess || hipDeviceGetAttribute(&cus, hipDeviceAttributeMultiprocessorCount, dev) != hipSuccess) { fprintf(stderr, "kernel_launch: device query failed\n"); grid = -1; return; }
        if (hipFuncSetAttribute((const void*)fwd_kernel, hipFuncAttributeMaxDynamicSharedMemorySize, LDS_BYTES) != hipSuccess) { fprintf(stderr, "kernel_launch: hipFuncSetAttribute failed\n"); grid = -1; return; }
        if (hipOccupancyMaxActiveBlocksPerMultiprocessor(&per_cu, (const void*)fwd_kernel, NWAVES * 64, LDS_BYTES) != hipSuccess || per_cu < 1) { fprintf(stderr, "kernel_launch: occupancy query reports %d blocks per CU\n", per_cu); (void)hipGetLastError(); per_cu = 1; }
        grid = cus;
    }
    if (grid < 0) return;
    if (hipMemsetAsync((char*)d_ws + WS_CTL, 0, CTL_ZERO_BYTES, stream) != hipSuccess) { fprintf(stderr, "kernel_launch: memset failed\n"); return; }
    Args a{};
    for (int i = 0; i < 18; ++i) a.in[i] = (const float*)d_in[i];
    a.out = (float*)d_out; a.ws = (unsigned char*)d_ws;
#ifndef PROBE_DUP
#define PROBE_DUP -1
#endif
    for (int li = 0; li < N_LAUNCHES; ++li) {
        a.ph_lo = (N_LAUNCHES == 1) ? 0 : li; a.ph_hi = (N_LAUNCHES == 1) ? NPHASE : li + 1; a.li = li;
#ifndef PROBE_SUB
#define PROBE_SUB 0
#endif
        if (N_LAUNCHES != 1 && li == PROBE_DUP) { a.pad = PROBE_SUB; hipLaunchKernelGGL(fwd_kernel, dim3(grid), dim3(NWAVES * 64), LDS_BYTES, stream, a); a.pad = 0; }
        hipLaunchKernelGGL(fwd_kernel, dim3(grid), dim3(NWAVES * 64), LDS_BYTES, stream, a);
        const hipError_t le = hipPeekAtLastError();
        if (le != hipSuccess) { fprintf(stderr, "kernel_launch: launch %d failed: %s\n", li, hipGetErrorName(le)); break; }
    }
}
```
